# Optimizing an MI355X kernel written in HIP

```python
import math
import numpy as np
import jax
import jax.numpy as jnp
from jax import lax

D_MODEL = 1024
BATCH = 4
SEQ = 8192
DEPTH = 2

GRID_W = 64
CTX_LEN = 256
N_EVEN = (DEPTH + 1) // 2
N_ODD = DEPTH // 2
EPS = 1e-6
ROPE_BASE = 10000.0
NEG_INF = -1e30
GLA_HEADS = 4
GLA_DK = 64
GLA_DV = 128
GLA_QK = GLA_HEADS * GLA_DK
GLA_V = GLA_HEADS * GLA_DV
GLA_RANK = 16
GLA_TAU = 16.0
GLA_CHUNK = 64
GLA_LOG_ALPHA_MIN = -1.0
S5_W = D_MODEL // 2
S5_H = 16
S5_G = S5_W // S5_H
S5_P = 64
DT_MIN = 1e-3
DT_MAX = 1e-1
NA_HEADS = 8
NA_DH = 64
NA_W = NA_HEADS * NA_DH
WIN_R = 8
WIN_C = 16
HY_W = D_MODEL // 2
HY_SHORT = 3
HY_EMB = 33
HY_ORD = 64
HY_DECAY_TARGET = 1e-2
HY_DECAY_SHORT_PCT = 0.3
HY_DECAY_LONG_PCT = 1.5
N_GROUPS = 4
EXP_PER_GROUP = 8
N_EXPERTS = N_GROUPS * EXP_PER_GROUP
D_EXPERT = D_MODEL // 2
TOP_K = 2
MOE_BLOCK = 256

EV_IN = 2 * GLA_QK + 2 * GLA_V + 2 * GLA_RANK + S5_W
EV_MIX = GLA_V + S5_W
OD_IN = 3 * NA_W + 3 * HY_W
OD_MIX = NA_W + HY_W

kernel_name = 'hybrid_gla_s5_natten_hyena_hmoe_dit'


def _rms(x):
    xf = x.astype(jnp.float32)
    return (xf * lax.rsqrt(jnp.mean(xf * xf, axis=-1, keepdims=True) + EPS)).astype(x.dtype)


def _modulate(h, shift, scale):
    return h * (1.0 + scale) + shift


def _rope_axis(x, pos):
    half = x.shape[-1] // 2
    freqs = ROPE_BASE ** (-jnp.arange(half, dtype=jnp.float32) / half)
    ang = pos.astype(jnp.float32)[:, None] * freqs
    cos, sin = jnp.cos(ang)[:, None, :], jnp.sin(ang)[:, None, :]
    x1, x2 = x[..., :half], x[..., half:]
    return jnp.concatenate([x1 * cos - x2 * sin, x1 * sin + x2 * cos], axis=-1)


def _rope_2d(x, rows, cols):
    d = x.shape[-1] // 2
    return jnp.concatenate([_rope_axis(x[..., :d], rows), _rope_axis(x[..., d:], cols)], axis=-1)


def _gla_chunked(q, k, v, log_a, s0, strict):
    bsz, seqlen, nh, _ = q.shape
    dv = v.shape[-1]
    n = seqlen // GLA_CHUNK
    rs = lambda t: t.reshape(bsz, n, GLA_CHUNK, nh, t.shape[-1])
    q, k, v, log_a = rs(q), rs(k), rs(v), rs(log_a)
    b = jnp.cumsum(log_a, axis=2)
    b_last = b[:, :, -1]
    q_e = q * jnp.exp(b)
    k_e = k * jnp.exp(-b)
    k_d = k * jnp.exp(b_last[:, :, None] - b)
    mask = jnp.tril(jnp.ones((GLA_CHUNK, GLA_CHUNK), dtype=bool), -1 if strict else 0)
    att = jnp.where(mask, jnp.einsum('bnihk,bnjhk->bnhij', q_e, k_e), 0.0)
    o_intra = jnp.einsum('bnhij,bnjhv->bnihv', att, v)
    upd = jnp.einsum('bnjhk,bnjhv->nbhkv', k_d, v)
    dec = jnp.exp(b_last).transpose(1, 0, 2, 3)

    def step(s, inp):
        d, u = inp
        return d[..., None] * s + u, s

    s_fin, s_before = lax.scan(step, s0, (dec, upd))
    o_inter = jnp.einsum('bnihk,nbhkv->bnihv', q_e, s_before)
    return (o_intra + o_inter).reshape(bsz, seqlen, nh, dv), s_fin


def _cmul(ar, ai, br, bi):
    return ar * br - ai * bi, ar * bi + ai * br


def _s5_discretise(lam_re, lam_im, log_dt, b_re, b_im):
    dt = jnp.exp(log_dt)[..., None]
    mag = jnp.exp(lam_re * dt)
    a_re, a_im = mag * jnp.cos(lam_im * dt), mag * jnp.sin(lam_im * dt)
    den = lam_re * lam_re + lam_im * lam_im
    nr = a_re - 1.0
    co_re = ((nr * lam_re + a_im * lam_im) / den)[..., None]
    co_im = ((a_im * lam_re - nr * lam_im) / den)[..., None]
    bb_re, bb_im = _cmul(co_re, co_im, b_re, b_im)
    return a_re, a_im, bb_re, bb_im


def _s5_scan_dir(u, a_re, a_im, bb_re, bb_im, c_re, c_im, h0_re, h0_im, reverse):
    if reverse:
        u = jnp.flip(u, 1)
    seqlen = u.shape[1]
    bu_re = jnp.einsum('blgh,gph->lbgp', u, bb_re)
    bu_im = jnp.einsum('blgh,gph->lbgp', u, bb_im)
    ir, ii = _cmul(a_re, a_im, h0_re, h0_im)
    bu_re = bu_re.at[0].add(ir)
    bu_im = bu_im.at[0].add(ii)
    ar = jnp.broadcast_to(a_re, (seqlen, 1) + a_re.shape)
    ai = jnp.broadcast_to(a_im, (seqlen, 1) + a_im.shape)

    def comb(e1, e2):
        ar1, ai1, br1, bi1 = e1
        ar2, ai2, br2, bi2 = e2
        a_r, a_i = _cmul(ar2, ai2, ar1, ai1)
        x_r, x_i = _cmul(ar2, ai2, br1, bi1)
        return a_r, a_i, x_r + br2, x_i + bi2

    _, _, h_re, h_im = lax.associative_scan(comb, (ar, ai, bu_re, bu_im), axis=0)
    y = jnp.einsum('ghp,lbgp->blgh', c_re, h_re) - jnp.einsum('ghp,lbgp->blgh', c_im, h_im)
    if reverse:
        y = jnp.flip(y, 1)
    return y, h_re[-1], h_im[-1]


def _even_mixer(h_c, h_l, rows, cols, w_in, w_out, wa2, ba, gnorm, s5, w_glu, need_ctx):
    f32 = jnp.float32
    splits = np.cumsum([GLA_QK, GLA_QK, GLA_V, GLA_V, 2 * GLA_RANK]).tolist()

    def project(h, rotate):
        bsz, seqlen, _ = h.shape
        q, k, v, g, a, u = jnp.split(h @ w_in, splits, axis=-1)
        q = q.reshape(bsz, seqlen, GLA_HEADS, GLA_DK)
        k = k.reshape(bsz, seqlen, GLA_HEADS, GLA_DK)
        if rotate:
            q, k = _rope_2d(q, rows, cols), _rope_2d(k, rows, cols)
        a = a.reshape(bsz, seqlen, 2, GLA_RANK)
        pre = (jnp.einsum('bldr,drk->bldk', a, wa2) + ba).astype(f32)
        la = jnp.maximum(jax.nn.log_sigmoid(pre) / GLA_TAU, GLA_LOG_ALPHA_MIN)
        la = la.reshape(bsz, seqlen, 2, GLA_HEADS, GLA_DK)
        return ((q * GLA_DK ** -0.5).astype(f32), k.astype(f32),
                v.reshape(bsz, seqlen, GLA_HEADS, GLA_DV).astype(f32), la, g,
                u.reshape(bsz, seqlen, S5_G, S5_H).astype(f32))

    q_c, k_c, v_c, la_c, g_c, u_c = project(h_c, False)
    q_l, k_l, v_l, la_l, g_l, u_l = project(h_l, True)
    fl = lambda t: jnp.flip(t, 1)
    bsz = h_l.shape[0]

    s0 = jnp.zeros((bsz, GLA_HEADS, GLA_DK, GLA_DV), f32)
    o_cf, s_cf = _gla_chunked(q_c, k_c, v_c, la_c[:, :, 0], s0, False)
    o_cb, s_cb = _gla_chunked(fl(q_c), fl(k_c), fl(v_c), fl(la_c[:, :, 1]), s0, True)
    o_lf, _ = _gla_chunked(q_l, k_l, v_l, la_l[:, :, 0], s_cf, False)
    o_lb, _ = _gla_chunked(fl(q_l), fl(k_l), fl(v_l), fl(la_l[:, :, 1]), s_cb, True)

    def gla_out(o, g):
        b_, l_ = o.shape[:2]
        return (_rms(o) * gnorm.astype(f32)).reshape(b_, l_, GLA_V) * jax.nn.silu(g.astype(f32))

    lam_re, lam_im, log_dt, b_re, b_im, c_re, c_im, d_skip = [t.astype(f32) for t in s5]
    a_re, a_im, bb_re, bb_im = _s5_discretise(lam_re, lam_im, log_dt, b_re, b_im)
    dirp = [(a_re[s], a_im[s], bb_re[s], bb_im[s], c_re[s], c_im[s]) for s in range(2)]
    h0 = jnp.zeros((bsz, S5_G, S5_P), f32)
    y_cf, hf_re, hf_im = _s5_scan_dir(u_c, *dirp[0], h0, h0, False)
    y_cb, hb_re, hb_im = _s5_scan_dir(u_c, *dirp[1], h0, h0, True)
    y_lf, _, _ = _s5_scan_dir(u_l, *dirp[0], hf_re, hf_im, False)
    y_lb, _, _ = _s5_scan_dir(u_l, *dirp[1], hb_re, hb_im, True)

    def s5_out(yf, yb, u):
        b_, l_ = u.shape[:2]
        y = jax.nn.gelu((yf + yb + d_skip * u).reshape(b_, l_, S5_W))
        return y * jax.nn.sigmoid(y @ w_glu.astype(f32))

    def merge(o_gla, y_s5, dtype):
        return (jnp.concatenate([o_gla, y_s5], axis=-1) @ w_out.astype(f32)).astype(dtype)

    mix_l = merge(gla_out(o_lf + fl(o_lb), g_l), s5_out(y_lf, y_lb, u_l), h_l.dtype)
    mix_c = merge(gla_out(o_cf + fl(o_cb), g_c), s5_out(y_cf, y_cb, u_c), h_c.dtype) if need_ctx else None
    return mix_c, mix_l


def _na_latent(q, k, v, k_c, v_c, rpb):
    bsz, seqlen, nh, dh = q.shape
    n_rows = seqlen // GRID_W
    wr = min(WIN_R, n_rows)
    ncb, kcols = GRID_W // WIN_C, 2 * WIN_C
    key_start = np.clip(np.arange(ncb) * WIN_C - WIN_C // 2, 0, GRID_W - kcols)
    key_cols = key_start[:, None] + np.arange(kcols)
    q_cols = np.arange(GRID_W).reshape(ncb, WIN_C)
    q_start = np.clip(q_cols - WIN_C // 2, 0, GRID_W - WIN_C)[..., None]
    kc = key_cols[:, None, :]
    col_valid = (kc >= q_start) & (kc < q_start + WIN_C)
    col_idx = np.clip(kc - q_cols[..., None] + WIN_C - 1, 0, 2 * WIN_C - 2)
    scale = dh ** -0.5
    n_loc = wr * kcols
    qg = q.reshape(bsz, n_rows, ncb, WIN_C, nh, dh)
    kg = k.reshape(bsz, n_rows, GRID_W, nh, dh)
    vg = v.reshape(bsz, n_rows, GRID_W, nh, dh)

    def row_block(r):
        r0 = jnp.clip(r - wr // 2, 0, n_rows - wr)
        q_r = lax.dynamic_index_in_dim(qg, r, axis=1, keepdims=False)
        k_r = lax.dynamic_slice_in_dim(kg, r0, wr, axis=1)[:, :, key_cols]
        v_r = lax.dynamic_slice_in_dim(vg, r0, wr, axis=1)[:, :, key_cols]
        s_loc = jnp.einsum('bjqhd,bwjkhd->bhjqwk', q_r, k_r).astype(jnp.float32) * scale
        row_idx = r0 + jnp.arange(wr) - r + WIN_R - 1
        bias = rpb[:, row_idx[None, None, :, None], col_idx[:, :, None, :]].astype(jnp.float32)
        s_loc = jnp.where(col_valid[:, :, None, :], s_loc + bias, NEG_INF)
        s_ctx = jnp.einsum('bjqhd,bkhd->bhjqk', q_r, k_c).astype(jnp.float32) * scale
        s = jnp.concatenate([s_loc.reshape(bsz, nh, ncb, WIN_C, n_loc), s_ctx], axis=-1)
        p = jax.nn.softmax(s, axis=-1).astype(v.dtype)
        o = (jnp.einsum('bhjqwk,bwjkhd->bjqhd', p[..., :n_loc].reshape(bsz, nh, ncb, WIN_C, wr, kcols), v_r)
             + jnp.einsum('bhjqk,bkhd->bjqhd', p[..., n_loc:], v_c))
        return o.reshape(bsz, GRID_W, nh, dh)

    out = lax.map(row_block, jnp.arange(n_rows))
    return out.transpose(1, 0, 2, 3, 4).reshape(bsz, seqlen, nh * dh)


def _hyena_filter(seqlen, fw1, fb1, fw2, fb2, fw3, fb3, freq, fw4):
    f32 = jnp.float32
    t = jnp.linspace(0.0, 1.0, seqlen, dtype=f32)[:, None]
    bands = (HY_EMB - 1) // 2
    w = 2.0 * math.pi * jnp.arange(seqlen, dtype=f32)[:, None] / seqlen
    f = jnp.linspace(1e-4, bands - 1, bands, dtype=f32)[None, :]
    feat = jnp.concatenate([t, jnp.cos(f * w), -jnp.sin(f * w)], axis=-1)
    h = jnp.sin(freq * (feat @ fw1 + fb1))
    h = jnp.sin(freq * (h @ fw2 + fb2))
    h = jnp.sin(freq * (h @ fw3 + fb3))
    h = (h @ fw4).reshape(seqlen, 2, HY_W)
    deltas = jnp.abs(jnp.linspace(math.log(HY_DECAY_TARGET) / HY_DECAY_LONG_PCT,
                                  math.log(HY_DECAY_TARGET) / HY_DECAY_SHORT_PCT, HY_W, dtype=f32))
    h = h * jnp.exp(-t * deltas)[:, None, :]
    return jnp.concatenate([h[:, 0], jnp.zeros((1, HY_W), f32), h[:0:-1, 1]], axis=0)


def _hyena(z, conv_w, conv_b, filt, bias):
    bsz, seqlen, _ = z.shape
    pad = HY_SHORT // 2
    zp = jnp.pad(z, ((0, 0), (pad, pad), (0, 0)))
    zc = conv_b + conv_w[0] * zp[:, 0:seqlen]
    for j in range(1, HY_SHORT):
        zc = zc + conv_w[j] * zp[:, j:j + seqlen]
    x0, x1, v = jnp.split(zc, 3, axis=-1)
    u = (x1 * v).astype(jnp.float32)
    filt = [p.astype(jnp.float32) for p in filt]
    kf = jnp.fft.rfft(_hyena_filter(seqlen, *filt), axis=0)
    y = jnp.fft.irfft(jnp.fft.rfft(u, n=2 * seqlen, axis=1) * kf, n=2 * seqlen, axis=1)[:, :seqlen]
    return x0.astype(jnp.float32) * (y + u * bias.astype(jnp.float32))


def _odd_mixer(h_c, h_l, w_in, w_out, qn, kn, rpb, conv_w, conv_b, filt, hbias, need_ctx):
    f32 = jnp.float32
    heads = lambda t: t.reshape(t.shape[0], t.shape[1], NA_HEADS, NA_DH)
    q_l, k_l, v_l, zh_l = jnp.split(h_l @ w_in, [NA_W, 2 * NA_W, 3 * NA_W], axis=-1)
    q_l, k_l, v_l = _rms(heads(q_l)) * qn, _rms(heads(k_l)) * kn, heads(v_l)
    if need_ctx:
        q_c, k_c, v_c, zh_c = jnp.split(h_c @ w_in, [NA_W, 2 * NA_W, 3 * NA_W], axis=-1)
    else:
        k_c, v_c = jnp.split(h_c @ w_in[:, NA_W:3 * NA_W], 2, axis=-1)
    k_c, v_c = _rms(heads(k_c)) * kn, heads(v_c)

    na_l = _na_latent(q_l, k_l, v_l, k_c, v_c, rpb).astype(f32)
    hy_l = _hyena(zh_l, conv_w, conv_b, filt, hbias)
    mix_l = (jnp.concatenate([na_l, hy_l], axis=-1) @ w_out.astype(f32)).astype(h_l.dtype)
    if not need_ctx:
        return None, mix_l
    q_c = _rms(heads(q_c)) * qn
    s = jnp.einsum('bqhd,bkhd->bhqk', q_c, k_c).astype(f32) * NA_DH ** -0.5
    na_c = jnp.einsum('bhqk,bkhd->bqhd', jax.nn.softmax(s, axis=-1).astype(v_c.dtype), v_c)
    na_c = na_c.reshape(h_c.shape[0], h_c.shape[1], NA_W).astype(f32)
    hy_c = _hyena(zh_c, conv_w, conv_b, filt, hbias)
    mix_c = (jnp.concatenate([na_c, hy_c], axis=-1) @ w_out.astype(f32)).astype(h_c.dtype)
    return mix_c, mix_l


def _moe(h, wg, bg, we, be, w1, w3, w2):
    n_tok, d = h.shape
    lg = (h @ wg + bg).astype(jnp.float32)
    grp = jnp.argmax(lg, axis=-1)
    g_w = jnp.max(jax.nn.softmax(lg, axis=-1), axis=-1, keepdims=True)
    le = (h @ we + be).astype(jnp.float32).reshape(n_tok, N_GROUPS, EXP_PER_GROUP)
    le = le[jnp.arange(n_tok), grp]
    top_p, top_i = lax.top_k(jax.nn.softmax(le, axis=-1), TOP_K)
    gate = (g_w * top_p / jnp.sum(top_p, axis=-1, keepdims=True)).reshape(-1)
    eid = (grp[:, None] * EXP_PER_GROUP + top_i).reshape(-1)
    tok = jnp.repeat(jnp.arange(n_tok), TOP_K)
    n_asg = n_tok * TOP_K
    order = jnp.argsort(eid)
    e_sorted = eid[order]
    counts = jnp.bincount(eid, length=N_EXPERTS)
    padded = (counts + MOE_BLOCK - 1) // MOE_BLOCK * MOE_BLOCK
    pad_end = jnp.cumsum(padded)
    pad_start = pad_end - padded
    cnt_start = jnp.cumsum(counts) - counts
    dest = pad_start[e_sorted] + jnp.arange(n_asg) - cnt_start[e_sorted]
    n_blocks = -(-n_asg // MOE_BLOCK) + N_EXPERTS
    tok_buf = jnp.full((n_blocks * MOE_BLOCK,), n_tok, jnp.int32).at[dest].set(tok[order])
    gate_buf = jnp.zeros((n_blocks * MOE_BLOCK,), h.dtype).at[dest].set(gate[order].astype(h.dtype))
    blk_e = jnp.minimum(jnp.searchsorted(pad_end, jnp.arange(n_blocks) * MOE_BLOCK, side='right'), N_EXPERTS - 1)
    xb = jnp.concatenate([h, jnp.zeros((1, d), h.dtype)])[tok_buf].reshape(n_blocks, MOE_BLOCK, d)

    def expert_block(args):
        xe, e = args
        return (jax.nn.silu(xe @ w1[e]) * (xe @ w3[e])) @ w2[e]

    yb = lax.map(expert_block, (xb, blk_e)).reshape(-1, d)
    out = jnp.zeros((n_tok + 1, d), yb.dtype).at[tok_buf].add(yb * gate_buf[:, None].astype(yb.dtype))
    return out[:n_tok]


def setup_inputs(seed: int = 0) -> dict:
    key = jax.random.key(seed)
    ks = iter(jax.random.split(key, 64))

    def nrm(shape, scale):
        return scale * jax.random.normal(next(ks), shape, jnp.float32)

    D = D_MODEL
    p = {}
    p['x'] = nrm((BATCH, SEQ, D), 1.0)
    p['c'] = nrm((BATCH, D), 1.0)
    p['ctx'] = nrm((BATCH, CTX_LEN, D), 1.0)
    p['c_ctx'] = nrm((D,), 1.0)
    p['ada_w'] = nrm((DEPTH, D, 6 * D), 0.5 * D ** -0.5)
    p['ada_b'] = nrm((DEPTH, 6 * D), 0.02)
    p['moe_wg'] = nrm((DEPTH, D, N_GROUPS), D ** -0.5)
    p['moe_bg'] = nrm((DEPTH, N_GROUPS), 0.01)
    p['moe_we'] = nrm((DEPTH, D, N_EXPERTS), D ** -0.5)
    p['moe_be'] = nrm((DEPTH, N_EXPERTS), 0.01)
    p['moe_w1'] = nrm((DEPTH, N_EXPERTS, D, D_EXPERT), D ** -0.5)
    p['moe_w3'] = nrm((DEPTH, N_EXPERTS, D, D_EXPERT), D ** -0.5)
    p['moe_w2'] = nrm((DEPTH, N_EXPERTS, D_EXPERT, D), D_EXPERT ** -0.5)
    p['ev_w_in'] = nrm((N_EVEN, D, EV_IN), D ** -0.5)
    p['ev_w_out'] = nrm((N_EVEN, EV_MIX, D), EV_MIX ** -0.5)
    p['gla_wa2'] = nrm((N_EVEN, 2, GLA_RANK, GLA_QK), GLA_RANK ** -0.5)
    p['gla_ba'] = nrm((N_EVEN, 2, GLA_QK), 0.5)
    p['gla_norm'] = 1.0 + nrm((N_EVEN, GLA_DV), 0.02)
    p['s5_lam_re'] = -0.5 + nrm((N_EVEN, 2, S5_G, S5_P), 0.01)
    p['s5_lam_im'] = math.pi * jnp.arange(S5_P, dtype=jnp.float32) + nrm((N_EVEN, 2, S5_G, S5_P), 0.01)
    p['s5_log_dt'] = jax.random.uniform(next(ks), (N_EVEN, 2, S5_G), jnp.float32, math.log(DT_MIN), math.log(DT_MAX))
    p['s5_b_re'] = nrm((N_EVEN, 2, S5_G, S5_P, S5_H), (2 * S5_H) ** -0.5)
    p['s5_b_im'] = nrm((N_EVEN, 2, S5_G, S5_P, S5_H), (2 * S5_H) ** -0.5)
    p['s5_c_re'] = nrm((N_EVEN, 2, S5_G, S5_H, S5_P), 2.0 * S5_P ** -0.5)
    p['s5_c_im'] = nrm((N_EVEN, 2, S5_G, S5_H, S5_P), 2.0 * S5_P ** -0.5)
    p['s5_d'] = nrm((N_EVEN, S5_G, S5_H), 0.5)
    p['s5_w_glu'] = nrm((N_EVEN, S5_W, S5_W), S5_W ** -0.5)
    p['od_w_in'] = nrm((N_ODD, D, OD_IN), D ** -0.5)
    p['od_w_out'] = nrm((N_ODD, OD_MIX, D), OD_MIX ** -0.5)
    p['na_q_norm'] = 1.0 + nrm((N_ODD, NA_DH), 0.02)
    p['na_k_norm'] = 1.0 + nrm((N_ODD, NA_DH), 0.02)
    p['na_rpb'] = nrm((N_ODD, NA_HEADS, 2 * WIN_R - 1, 2 * WIN_C - 1), 0.02)
    p['hy_conv_w'] = nrm((N_ODD, HY_SHORT, 3 * HY_W), HY_SHORT ** -0.5)
    p['hy_conv_b'] = nrm((N_ODD, 3 * HY_W), 0.02)
    p['hy_fw1'] = nrm((N_ODD, HY_EMB, HY_ORD), HY_EMB ** -0.5)
    p['hy_fb1'] = nrm((N_ODD, HY_ORD), 0.1)
    p['hy_fw2'] = nrm((N_ODD, HY_ORD, HY_ORD), HY_ORD ** -0.5)
    p['hy_fb2'] = nrm((N_ODD, HY_ORD), 0.1)
    p['hy_fw3'] = nrm((N_ODD, HY_ORD, HY_ORD), HY_ORD ** -0.5)
    p['hy_fb3'] = nrm((N_ODD, HY_ORD), 0.1)
    p['hy_freq'] = 1.0 + nrm((N_ODD, HY_ORD), 0.02)
    p['hy_fw4'] = nrm((N_ODD, HY_ORD, 2 * HY_W), 0.02)
    p['hy_bias'] = nrm((N_ODD, HY_W), 0.5)
    return p


def reference(x, c, ctx, c_ctx, ada_w, ada_b, moe_wg, moe_bg, moe_we, moe_be, moe_w1, moe_w3, moe_w2,
              ev_w_in, ev_w_out, gla_wa2, gla_ba, gla_norm, s5_lam_re, s5_lam_im, s5_log_dt,
              s5_b_re, s5_b_im, s5_c_re, s5_c_im, s5_d, s5_w_glu, od_w_in, od_w_out, na_q_norm,
              na_k_norm, na_rpb, hy_conv_w, hy_conv_b, hy_fw1, hy_fb1, hy_fw2, hy_fb2, hy_fw3,
              hy_fb3, hy_freq, hy_fw4, hy_bias):
    bsz, seqlen, _ = x.shape
    pos = jnp.arange(seqlen)
    rows, cols = pos // GRID_W, pos % GRID_W
    x_l, x_c = x, ctx
    for i in range(DEPTH):
        last = i == DEPTH - 1
        j = i // 2
        mod_l = (jax.nn.silu(c) @ ada_w[i] + ada_b[i]).reshape(bsz, 6, 1, D_MODEL)
        mod_c = (jax.nn.silu(c_ctx) @ ada_w[i] + ada_b[i]).reshape(6, 1, 1, D_MODEL)
        h_l = _modulate(_rms(x_l), mod_l[:, 0], mod_l[:, 1])
        h_c = _modulate(_rms(x_c), mod_c[0], mod_c[1])
        if i % 2 == 0:
            m_c, m_l = _even_mixer(h_c, h_l, rows, cols, ev_w_in[j], ev_w_out[j], gla_wa2[j], gla_ba[j],
                                   gla_norm[j], (s5_lam_re[j], s5_lam_im[j], s5_log_dt[j], s5_b_re[j],
                                                 s5_b_im[j], s5_c_re[j], s5_c_im[j], s5_d[j]),
                                   s5_w_glu[j], not last)
        else:
            m_c, m_l = _odd_mixer(h_c, h_l, od_w_in[j], od_w_out[j], na_q_norm[j], na_k_norm[j], na_rpb[j],
                                  hy_conv_w[j], hy_conv_b[j],
                                  (hy_fw1[j], hy_fb1[j], hy_fw2[j], hy_fb2[j], hy_fw3[j], hy_fb3[j],
                                   hy_freq[j], hy_fw4[j]), hy_bias[j], not last)
        x_l = x_l + mod_l[:, 2] * m_l
        moe_p = (moe_wg[i], moe_bg[i], moe_we[i], moe_be[i], moe_w1[i], moe_w3[i], moe_w2[i])
        h2_l = _modulate(_rms(x_l), mod_l[:, 3], mod_l[:, 4]).reshape(-1, D_MODEL)
        if last:
            y_l = _moe(h2_l, *moe_p)
        else:
            x_c = x_c + mod_c[2] * m_c
            h2_c = _modulate(_rms(x_c), mod_c[3], mod_c[4]).reshape(-1, D_MODEL)
            y = _moe(jnp.concatenate([h2_c, h2_l], axis=0), *moe_p)
            n_c = h2_c.shape[0]
            x_c = x_c + mod_c[5] * y[:n_c].reshape(x_c.shape)
            y_l = y[n_c:]
        x_l = x_l + mod_l[:, 5] * y_l.reshape(x_l.shape)
    return x_l
```

```cpp
#include <hip/hip_runtime.h>
#include <hip/hip_cooperative_groups.h>
#include <cstdio>
#include <cstdint>
#include <cmath>

#define LAS __attribute__((address_space(3)))
#define GAS __attribute__((address_space(1)))
typedef unsigned short bf16_t;
typedef short bf16x8 __attribute__((ext_vector_type(8)));
typedef short bf16x4 __attribute__((ext_vector_type(4)));
typedef float f32x4 __attribute__((ext_vector_type(4)));
typedef float f32x2 __attribute__((ext_vector_type(2)));
typedef unsigned u32x4 __attribute__((ext_vector_type(4)));
typedef unsigned u32x2 __attribute__((ext_vector_type(2)));

constexpr int D = 1024, NB = 4, SEQ = 8192, CTX = 256;
constexpr int NCTX = NB * CTX;
constexpr int NLAT = NB * SEQ;
constexpr int NTOK = NCTX + NLAT;
constexpr int NEXP = 32;
constexpr float EPS = 1e-6f;
constexpr int S5TC = 32;
constexpr int S5KU = S5TC * 16;
constexpr int S5K = S5KU + 256;
constexpr int S5ROWS = 1280;
constexpr int S5NCH = NTOK / S5TC;
constexpr int GCH = 64;
constexpr int GNCH = NTOK / GCH;
constexpr int GSEQ = (CTX + SEQ) / GCH;
constexpr int MOE_TILES_MAX = 296;
constexpr int FFTN = 16384;

constexpr size_t MiB = 1u << 20;
constexpr size_t WS_MISC = 0;
constexpr size_t WS_WSMALL = 8 * MiB;
constexpr size_t WS_WMOE = 56 * MiB;
constexpr size_t WS_ABUF = 152 * MiB;
constexpr size_t WS_X1 = 218 * MiB;
constexpr size_t WS_R3 = 350 * MiB;
constexpr size_t WS_END = 576 * MiB;
constexpr size_t W_IN0 = WS_WSMALL;
constexpr size_t W_OUT0 = W_IN0 + 2560 * 1024 * 2;
constexpr size_t W_GLU = W_OUT0 + 1024 * 1024 * 2;
constexpr size_t W_IN1 = W_GLU + 512 * 512 * 2;
constexpr size_t W_OUT1 = W_IN1 + 3072 * 1024 * 2;
constexpr size_t W_S3 = W_OUT1 + 1024 * 1024 * 2;
constexpr size_t W_S1 = W_S3 + (size_t)32 * 512 * 768 * 2;
static_assert(W_S1 + (size_t)32 * 256 * 512 * 2 <= WS_WMOE, "wsmall");
constexpr size_t W_M13 = WS_WMOE;
constexpr size_t W_M2 = WS_WMOE + (size_t)32 * 1024 * 1024 * 2;
constexpr size_t B_HF = WS_WMOE;
constexpr size_t B_MIX1 = WS_WMOE;
constexpr size_t B_Q1 = WS_WMOE + 64 * MiB;
constexpr size_t B_ABUF = WS_ABUF;
constexpr size_t B_ZS5 = WS_ABUF;
constexpr size_t B_YG = WS_ABUF;
constexpr size_t B_HYT = WS_ABUF;
constexpr size_t B_X1 = WS_X1;
constexpr size_t B_QK = WS_X1;
constexpr size_t B_VT = WS_X1 + 33 * MiB;
constexpr size_t B_G = WS_X1 + 66 * MiB;
constexpr size_t B_DEC = WS_X1 + 102 * MiB;
constexpr size_t B_AS5 = WS_R3;
constexpr size_t B_UPD = WS_R3 + 60 * MiB;
constexpr size_t B_MIX0 = WS_R3 + 126 * MiB;
constexpr size_t B_LA = WS_R3 + 192 * MiB;
constexpr size_t B_ACT = WS_R3;
constexpr size_t B_YB = WS_R3 + 74 * MiB;
constexpr size_t B_KF = WS_R3;
constexpr size_t B_K1 = WS_R3 + 64 * MiB;
constexpr size_t B_VT1 = WS_R3 + 97 * MiB;
constexpr size_t B_ZHT = WS_R3 + 130 * MiB;
static_assert(B_LA + (size_t)NTOK * 512 * 2 <= WS_END && B_ZHT + (size_t)1536 * 32768 * 2 <= WS_END && B_YB + (size_t)MOE_TILES_MAX * 256 * 1024 * 2 <= WS_END && B_MIX0 + (size_t)NTOK * 1024 * 2 <= WS_END, "arena");
constexpr size_t M_CTL = 0;
constexpr size_t CTL_BYTES = 65536;
constexpr size_t M_MOD = 65536;
constexpr size_t M_TW = M_MOD + 245760;
constexpr size_t M_ROPE = M_TW + 131072;
constexpr size_t M_H3 = M_ROPE + 16384;
constexpr size_t M_ROUTE = M_H3 + 2097152;
constexpr size_t M_HIST = M_ROUTE + 1081344;
constexpr size_t M_TOKBUF = M_HIST + 32768;
constexpr size_t M_GATEBUF = M_TOKBUF + 303104;
constexpr size_t M_TILES = M_GATEBUF + 303104;
constexpr size_t M_KERN = 5 * MiB;
static_assert(M_TILES + 4096 <= M_KERN && M_KERN + 2 * MiB <= 8 * MiB, "misc");

__device__ __forceinline__ float bf2f(unsigned v) { return __uint_as_float(v << 16); }
__device__ __forceinline__ unsigned f2bf(float f) { return (unsigned)__builtin_bit_cast(unsigned short, (__bf16)f); }
typedef __bf16 bf16x2_t __attribute__((ext_vector_type(2)));
__device__ __forceinline__ unsigned pk2(float lo, float hi) { const f32x2 v = {lo, hi}; return __builtin_bit_cast(unsigned, __builtin_convertvector(v, bf16x2_t)); }
__device__ __forceinline__ float wave_sum(float v) {
#pragma unroll
    for (int o = 1; o < 64; o <<= 1) v += __shfl_xor(v, o);
    return v;
}
__device__ __forceinline__ float silu_f(float x) { return x * __builtin_amdgcn_rcpf(1.f + __expf(-x)); }
__device__ __forceinline__ float sigmoid_f(float x) { return __builtin_amdgcn_rcpf(1.f + __expf(-x)); }
__device__ __forceinline__ float gelu_tanh_f(float x) { const float u = 0.7978845608028654f * (x + 0.044715f * x * x * x); return x * __builtin_amdgcn_rcpf(1.f + __expf(-2.f * u)); }
__device__ __forceinline__ float logsigmoid_f(float x) { return fminf(x, 0.f) - __logf(1.f + __expf(-fabsf(x))); }
#define LDS_WAIT() asm volatile("s_waitcnt lgkmcnt(0)" ::: "memory")
#define VM_WAIT() asm volatile("s_waitcnt vmcnt(0)" ::: "memory")
namespace g8 {
constexpr int BM = 256, BK = 64, HALF = 128, HTB = HALF * BK * 2, STAGE_BYTES = 8 * HTB;
__host__ __device__ __forceinline__ int lds_byte(int r, int c) { const int st = (r >> 4) * 2 + (c >> 5), rr = r & 15, cc = c & 31, ob = rr * 64 + cc * 2; return st * 1024 + (ob ^ (((ob >> 9) & 1) << 5)); }
__host__ __device__ __forceinline__ void stage_rc(int b, int& R, int& C) { const int st = b / 1024, sb = b % 1024, swz = sb ^ (((sb >> 9) & 1) << 5); R = (st >> 1) * 16 + swz / 64; C = (st & 1) * 32 + (swz % 64) / 2; }
__host__ __device__ __forceinline__ int perm32(int rho) { const int n = rho >> 4, i = rho & 15; return 8 * (i >> 2) + 4 * n + (i & 3); }

struct Unit { const char* a; const char* b; const int* rows; int pm, pn, aux, half; };

template <class Epi, class Sched, bool GATHER>
__device__ __forceinline__ void gemm_phase(LAS unsigned char* lds, const int lda, const int K, const Sched& S, const Epi& E) {
    const int tid = threadIdx.x, wid = __builtin_amdgcn_readfirstlane(tid >> 6), lane = tid & 63, wr = wid >> 2, wc = wid & 3, fr = lane & 15, fq = lane >> 4;
    const int nt = K / BK;
    int sR[2], sC[2];
    unsigned voffB[2];
#pragma unroll
    for (int i = 0; i < 2; ++i) { stage_rc(tid * 16 + i * 8192, sR[i], sC[i]); const int Rb = Epi::PERM ? ((sR[i] & ~31) + perm32(sR[i] & 31)) : sR[i]; voffB[i] = (unsigned)(Rb * K + sC[i]) * 2u; }
    unsigned vAc[2][2], vAn[2][2];
    const size_t kstep = (size_t)(BK * 2);
    const size_t hstepB = (size_t)HALF * K * 2;
    const unsigned ldsw = (unsigned)wid * 1024u;
    const int aoff = lds_byte(wr * 64 + fr, fq * 8), boff = lds_byte(wc * 32 + fr, fq * 8);
#define G8_SA(b, h) (((b) * 2 + (h)) * HTB)
#define G8_SB(b, h) ((4 + (b) * 2 + (h)) * HTB)
#define G8_STAGE_B(bufoff, gbase) do { _Pragma("unroll") for (int _i = 0; _i < 2; ++_i) \
        __builtin_amdgcn_global_load_lds((const unsigned*)((const char*)(gbase) + voffB[_i]), (LAS unsigned*)(lds + (bufoff) + ldsw + _i * 8192), 16, 0, 0); } while (0)
#define G8_STAGE_A(bufoff, gbase, h, NX) do { _Pragma("unroll") for (int _i = 0; _i < 2; ++_i) \
        __builtin_amdgcn_global_load_lds((const unsigned*)((const char*)(gbase) + ((NX) ? vAn[h][_i] : vAc[h][_i])), (LAS unsigned*)(lds + (bufoff) + ldsw + _i * 8192), 16, 0, 0); } while (0)
#define G8_LDA(dst, b, h) do { _Pragma("unroll") for (int m = 0; m < 4; ++m) _Pragma("unroll") for (int k = 0; k < 2; ++k) dst[m][k] = *(const LAS bf16x8*)(lds + G8_SA(b, h) + aoff + m * 2048 + k * 1024); } while (0)
#define G8_LDB(dst, b, h) do { _Pragma("unroll") for (int n = 0; n < 2; ++n) _Pragma("unroll") for (int k = 0; k < 2; ++k) dst[n][k] = *(const LAS bf16x8*)(lds + G8_SB(b, h) + boff + n * 2048 + k * 1024); } while (0)
#define G8_MMA(ai, bj, At, Bt) do { __builtin_amdgcn_s_setprio(1); _Pragma("unroll") for (int m = 0; m < 4; ++m) _Pragma("unroll") for (int n = 0; n < 2; ++n) _Pragma("unroll") for (int k = 0; k < 2; ++k) \
        acc[ai][bj][m][n] = __builtin_amdgcn_mfma_f32_16x16x32_bf16(Bt[n][k], At[m][k], acc[ai][bj][m][n], 0, 0, 0); __builtin_amdgcn_s_setprio(0); } while (0)
#define G8_WAIT_V(n) asm volatile("s_waitcnt vmcnt(" #n ")" ::: "memory")
#define G8_WAIT_L(n) asm volatile("s_waitcnt lgkmcnt(" #n ")" ::: "memory")
#define G8_BAR __builtin_amdgcn_s_barrier()
#define G8_SCHED __builtin_amdgcn_sched_barrier(0)
#define G8_VA(dst, u) do { _Pragma("unroll") for (int _h = 0; _h < 2; ++_h) _Pragma("unroll") for (int _i = 0; _i < 2; ++_i) { \
        const int _row = GATHER ? (u).rows[sR[_i] + 128 * _h] : (sR[_i] + 128 * _h); dst[_h][_i] = (unsigned)(_row * lda + sC[_i]) * 2u; } } while (0)
    Unit cur, nxt; int ui = 0;
    if (!S.next(0, cur)) return;
    f32x4 acc[2][2][4][2];
#pragma unroll
    for (int a = 0; a < 2; ++a)
#pragma unroll
        for (int b = 0; b < 2; ++b)
#pragma unroll
            for (int m = 0; m < 4; ++m)
#pragma unroll
                for (int n = 0; n < 2; ++n) acc[a][b][m][n] = (f32x4){0.f, 0.f, 0.f, 0.f};
    bf16x8 At[4][2], B0[2][2], B1[2][2];
    G8_VA(vAc, cur);
#pragma unroll
    for (int _h = 0; _h < 2; ++_h)
#pragma unroll
        for (int _i = 0; _i < 2; ++_i) vAn[_h][_i] = vAc[_h][_i];
    const char* cA = cur.a; const char* cB = cur.b;
    {
        const char* a0 = cA; const char* a1p = cA + kstep;
        G8_STAGE_B(G8_SB(0, 0), cB); G8_STAGE_B(G8_SB(0, 1), cB + hstepB); G8_STAGE_A(G8_SA(0, 0), a0, 0, false); G8_STAGE_A(G8_SA(0, 1), a0, 1, false);
        if (wr == 1) G8_BAR;
        G8_WAIT_V(2); G8_BAR;
        G8_STAGE_B(G8_SB(1, 0), cB + kstep); G8_STAGE_A(G8_SA(1, 0), a1p, 0, false); G8_STAGE_B(G8_SB(1, 1), cB + hstepB + kstep);
        G8_WAIT_V(6); G8_BAR;
    }
    for (;;) {
        const bool has_next = S.next(ui + 1, nxt);
        if (GATHER) { if (has_next) { G8_VA(vAn, nxt); } }
        const char* nA = has_next ? nxt.a : cA; const char* nB = has_next ? nxt.b : cB;
        for (int t = 0; t < nt; t += 2) {
            const bool last = (t == nt - 2);
            const char* a1 = cA + (size_t)(t + 1) * kstep;
            const char* a2 = last ? nA : cA + (size_t)(t + 2) * kstep;
            const char* a3 = a2 + kstep;
            const char* b2 = last ? nB : cB + (size_t)(t + 2) * kstep;
            const char* b3 = b2 + kstep;
            const bool nx = GATHER ? (last && has_next) : false;
            G8_LDB(B0, 0, 0); G8_LDB(B1, 0, 1); G8_SCHED; G8_LDA(At, 0, 0); G8_STAGE_A(G8_SA(1, 1), a1, 1, false);
            G8_WAIT_V(8); G8_WAIT_L(0); G8_BAR; if (cur.half != 1) { G8_MMA(0, 0, At, B0); G8_MMA(0, 1, At, B1); } G8_BAR; G8_SCHED;
            G8_LDA(At, 0, 1); G8_STAGE_B(G8_SB(0, 0), b2); G8_STAGE_B(G8_SB(0, 1), b2 + hstepB); G8_STAGE_A(G8_SA(0, 0), a2, 0, nx);
            G8_WAIT_V(8); G8_WAIT_L(0); G8_BAR; if (cur.half != 0) { G8_MMA(1, 0, At, B0); G8_MMA(1, 1, At, B1); } G8_BAR; G8_SCHED;
            G8_LDB(B0, 1, 0); G8_LDB(B1, 1, 1); G8_SCHED; G8_LDA(At, 1, 0); G8_STAGE_A(G8_SA(0, 1), a2, 1, nx);
            G8_WAIT_V(8); G8_WAIT_L(0); G8_BAR; if (cur.half != 1) { G8_MMA(0, 0, At, B0); G8_MMA(0, 1, At, B1); } G8_BAR; G8_SCHED;
            G8_LDA(At, 1, 1); G8_STAGE_B(G8_SB(1, 0), b3); G8_STAGE_B(G8_SB(1, 1), b3 + hstepB); G8_STAGE_A(G8_SA(1, 0), a3, 0, nx);
            G8_WAIT_V(8); G8_WAIT_L(0); G8_BAR; if (cur.half != 0) { G8_MMA(1, 0, At, B0); G8_MMA(1, 1, At, B1); } G8_BAR; G8_SCHED;
        }
        if (wr == 0) G8_BAR;
        E(acc, cur, wr, wc, fr, fq);
        if (!has_next) break;
#pragma unroll
        for (int a = 0; a < 2; ++a)
#pragma unroll
            for (int b = 0; b < 2; ++b)
#pragma unroll
                for (int m = 0; m < 4; ++m)
#pragma unroll
                    for (int n = 0; n < 2; ++n) acc[a][b][m][n] = (f32x4){0.f, 0.f, 0.f, 0.f};
        cur = nxt; cA = nA; cB = nB; ++ui;
        if (GATHER) {
#pragma unroll
            for (int _h = 0; _h < 2; ++_h)
#pragma unroll
                for (int _i = 0; _i < 2; ++_i) vAc[_h][_i] = vAn[_h][_i];
        }
        if (wr == 1) G8_BAR;
    }
    G8_WAIT_V(0);
    G8_BAR;
#undef G8_SA
#undef G8_SB
#undef G8_STAGE_A
#undef G8_STAGE_B
#undef G8_LDA
#undef G8_LDB
#undef G8_MMA
#undef G8_WAIT_V
#undef G8_WAIT_L
#undef G8_BAR
#undef G8_SCHED
#undef G8_VA
}

struct DenseOrder {
    int nM, nN, nwg, G, c;
    __device__ __forceinline__ void init(int nM_, int nN_, int G_, int c_) { nM = nM_; nN = nN_; nwg = nM * nN; G = G_; c = c_; }
    __device__ __forceinline__ bool mapL(int L, int& pm, int& pn) const {
        if (L >= nwg) return false;
        int wgid = L; { const int q = nwg / 8, r = nwg % 8, xcd = wgid % 8, off = wgid / 8; wgid = (xcd < r ? xcd * (q + 1) : r * (q + 1) + (xcd - r) * q) + off; }
        const int nig = 8 * nN, gid = wgid / nig, fm = gid * 8, gsz = (nM - fm) < 8 ? (nM - fm) : 8;
        pm = fm + ((wgid % nig) % gsz); pn = (wgid % nig) / gsz; return true;
    }
};
__device__ __forceinline__ bool tail_split(int i, int G, int c, int U, int& L, int& half) {
    const int R = U / G, tail = U - R * G;
    if (c < 0) return false;
    if (i < R) { L = i * G + c; half = -1; return true; }
    if (i > R || tail == 0) return false;
    if (2 * tail <= G) { if (c >= 2 * tail) return false; L = R * G + (c >> 1); half = c & 1; return true; }
    if (c >= tail) return false;
    L = R * G + c; half = -1; return true;
}
}
using g8::Unit;
__device__ __forceinline__ u32x4 pack8(const f32x4 a, const f32x4 b) { u32x4 w; w.x = pk2(a[0], a[1]); w.y = pk2(a[2], a[3]); w.z = pk2(b[0], b[1]); w.w = pk2(b[2], b[3]); return w; }

__device__ __forceinline__ int tok_b5(int T) { return T < NCTX ? 4 : (T - NCTX) / SEQ; }
__device__ __forceinline__ int s5_row_of_chunk(int ch  ) { return ch >= NCTX / S5TC ? ch - NCTX / S5TC : 1024 + ch; }

struct EpiIn0 {
    static constexpr bool PERM = true;
    bf16_t *QK, *VT, *G, *AS5, *LA; const float* ba;
    __device__ __forceinline__ void operator()(const f32x4 (&acc)[2][2][4][2], const Unit& u, int wr, int wc, int fr, int fq) const {
#pragma unroll
        for (int ai = 0; ai < 2; ++ai)
#pragma unroll
            for (int m = 0; m < 4; ++m) {
                if (u.half >= 0 && u.half != ai) continue;
                const int T = u.pm * 256 + ai * 128 + wr * 64 + m * 16 + fr;
#pragma unroll
                for (int bj = 0; bj < 2; ++bj) {
                    const int c = u.pn * 256 + bj * 128 + wc * 32 + fq * 8;
                    const f32x4 v0 = acc[ai][bj][m][0], v1 = acc[ai][bj][m][1];
                    if (u.pn < 2) { *(u32x4*)(QK + (size_t)T * 512 + c) = pack8(v0, v1); }
                    else if (u.pn < 4) {
                        const int cc = c - 512, h = cc >> 7, dv = cc & 127, ch = T >> 6, t = T & 63;
                        bf16_t* p = VT + ((size_t)(ch * 4 + h) * 128 + dv) * 64 + t;
#pragma unroll
                        for (int j = 0; j < 4; ++j) { p[(size_t)j * 64] = (bf16_t)f2bf(v0[j]); p[(size_t)(j + 4) * 64] = (bf16_t)f2bf(v1[j]); }
                    }
                    else if (u.pn < 6) { *(u32x4*)(G + (size_t)T * 512 + (c - 1024)) = pack8(v0, v1); }
                    else if (u.pn < 8) {
                        const int cc = c - 1536, g = cc >> 4, hh = cc & 15, nrow = s5_row_of_chunk(T >> 5), t = T & 31;
                        *(u32x4*)(AS5 + ((size_t)g * S5ROWS + nrow) * S5K + t * 16 + hh) = pack8(v0, v1);
                    }
                    else { const int cc = c - 2048; const f32x4 b0 = *(const f32x4*)(ba + cc), b1 = *(const f32x4*)(ba + cc + 4); f32x4 l0, l1;
#pragma unroll
                        for (int j = 0; j < 4; ++j) { l0[j] = fmaxf(logsigmoid_f(v0[j] + b0[j]) * (1.f / 16.f), -1.f); l1[j] = fmaxf(logsigmoid_f(v1[j] + b1[j]) * (1.f / 16.f), -1.f); }
                        *(u32x4*)(LA + (size_t)T * 512 + cc) = pack8(l0, l1); }
                }
            }
    }
};
struct EpiS1 {
    static constexpr bool PERM = false;
    float* Z;
    __device__ __forceinline__ void operator()(const f32x4 (&acc)[2][2][4][2], const Unit& u, int wr, int wc, int fr, int fq) const {
#pragma unroll
        for (int ai = 0; ai < 2; ++ai)
#pragma unroll
            for (int m = 0; m < 4; ++m) {
                if (u.half >= 0 && u.half != ai) continue;
                const int nrow = u.pm * 256 + ai * 128 + wr * 64 + m * 16 + fr;
                if (nrow < S5NCH) {
                    float* zr = Z + ((size_t)u.aux * S5ROWS + nrow) * 256;
#pragma unroll
                    for (int bj = 0; bj < 2; ++bj)
#pragma unroll
                        for (int n = 0; n < 2; ++n) *(f32x4*)(zr + bj * 128 + wc * 32 + n * 16 + fq * 4) = acc[ai][bj][m][n];
                }
            }
    }
};
struct EpiS3 {
    static constexpr bool PERM = true;
    bf16_t* YG;
    __device__ __forceinline__ void operator()(const f32x4 (&acc)[2][2][4][2], const Unit& u, int wr, int wc, int fr, int fq) const {
#pragma unroll
        for (int ai = 0; ai < 2; ++ai)
#pragma unroll
            for (int m = 0; m < 4; ++m) {
                if (u.half >= 0 && u.half != ai) continue;
                const int nrow = u.pm * 256 + ai * 128 + wr * 64 + m * 16 + fr;
                if (nrow < S5NCH) {
                    const int T0 = nrow < 1024 ? NCTX + nrow * S5TC : (nrow - 1024) * S5TC;
#pragma unroll
                    for (int bj = 0; bj < 2; ++bj) {
                        const int c = u.pn * 256 + bj * 128 + wc * 32 + fq * 8, t = c >> 4, hh = c & 15;
                        f32x4 v0 = acc[ai][bj][m][0], v1 = acc[ai][bj][m][1];
#pragma unroll
                        for (int j = 0; j < 4; ++j) { v0[j] = gelu_tanh_f(v0[j]); v1[j] = gelu_tanh_f(v1[j]); }
                        *(u32x4*)(YG + (size_t)(T0 + t) * 512 + u.aux * 16 + hh) = pack8(v0, v1);
                    }
                }
            }
    }
};
struct EpiGlu {
    static constexpr bool PERM = true;
    const bf16_t* YG; bf16_t* MIX;
    __device__ __forceinline__ void operator()(const f32x4 (&acc)[2][2][4][2], const Unit& u, int wr, int wc, int fr, int fq) const {
#pragma unroll
        for (int ai = 0; ai < 2; ++ai)
#pragma unroll
            for (int m = 0; m < 4; ++m) {
                if (u.half >= 0 && u.half != ai) continue;
                const int T = u.pm * 256 + ai * 128 + wr * 64 + m * 16 + fr;
#pragma unroll
                for (int bj = 0; bj < 2; ++bj) {
                    const int c = u.pn * 256 + bj * 128 + wc * 32 + fq * 8;
                    const u32x4 y = *(const u32x4*)(YG + (size_t)T * 512 + c);
                    f32x4 v0 = acc[ai][bj][m][0], v1 = acc[ai][bj][m][1];
                    v0[0] = bf2f(y.x & 0xffffu) * sigmoid_f(v0[0]); v0[1] = bf2f(y.x >> 16) * sigmoid_f(v0[1]);
                    v0[2] = bf2f(y.y & 0xffffu) * sigmoid_f(v0[2]); v0[3] = bf2f(y.y >> 16) * sigmoid_f(v0[3]);
                    v1[0] = bf2f(y.z & 0xffffu) * sigmoid_f(v1[0]); v1[1] = bf2f(y.z >> 16) * sigmoid_f(v1[1]);
                    v1[2] = bf2f(y.w & 0xffffu) * sigmoid_f(v1[2]); v1[3] = bf2f(y.w >> 16) * sigmoid_f(v1[3]);
                    *(u32x4*)(MIX + (size_t)T * 1024 + 512 + c) = pack8(v0, v1);
                }
            }
    }
};
__device__ __forceinline__ void unpack8f(const u32x4 r, f32x4& a, f32x4& b) {
    a[0] = bf2f(r.x & 0xffffu); a[1] = bf2f(r.x >> 16); a[2] = bf2f(r.y & 0xffffu); a[3] = bf2f(r.y >> 16);
    b[0] = bf2f(r.z & 0xffffu); b[1] = bf2f(r.z >> 16); b[2] = bf2f(r.w & 0xffffu); b[3] = bf2f(r.w >> 16);
}
struct EpiOut {
    static constexpr bool PERM = true;
    const float* x; const float* ctx; bf16_t* X1; const float* mod; int layer1;
    __device__ __forceinline__ void operator()(const f32x4 (&acc)[2][2][4][2], const Unit& u, int wr, int wc, int fr, int fq) const {
#pragma unroll
        for (int ai = 0; ai < 2; ++ai)
#pragma unroll
            for (int m = 0; m < 4; ++m) {
                if (u.half >= 0 && u.half != ai) continue;
                const int T = u.pm * 256 + ai * 128 + wr * 64 + m * 16 + fr;
                const float* src = T < NCTX ? ctx + (size_t)T * 1024 : x + (size_t)(T - NCTX) * 1024;
                const float* gate = mod + tok_b5(T) * 6144 + 2 * 1024;
                bf16_t* dst = X1 + (size_t)T * 1024;
#pragma unroll
                for (int bj = 0; bj < 2; ++bj) {
                    const int c = u.pn * 256 + bj * 128 + wc * 32 + fq * 8;
                    f32x4 x0, x1;
                    if (layer1) unpack8f(*(const u32x4*)(dst + c), x0, x1); else { x0 = *(const f32x4*)(src + c); x1 = *(const f32x4*)(src + c + 4); }
                    const f32x4 g0 = *(const f32x4*)(gate + c), g1 = *(const f32x4*)(gate + c + 4);
                    *(u32x4*)(dst + c) = pack8(x0 + g0 * acc[ai][bj][m][0], x1 + g1 * acc[ai][bj][m][1]);
                }
            }
    }
};
struct EpiM1 {
    static constexpr bool PERM = true;
    bf16_t* ACT;
    __device__ __forceinline__ void operator()(const f32x4 (&acc)[2][2][4][2], const Unit& u, int wr, int wc, int fr, int fq) const {
#pragma unroll
        for (int ai = 0; ai < 2; ++ai)
#pragma unroll
            for (int m = 0; m < 4; ++m) {
                if (u.half >= 0 && u.half != ai) continue;
                const int row = u.pm * 256 + ai * 128 + wr * 64 + m * 16 + fr;
                f32x4 v0, v1;
#pragma unroll
                for (int j = 0; j < 4; ++j) { v0[j] = silu_f(acc[ai][0][m][0][j]) * acc[ai][1][m][0][j]; v1[j] = silu_f(acc[ai][0][m][1][j]) * acc[ai][1][m][1][j]; }
                *(u32x4*)(ACT + (size_t)row * 512 + u.pn * 128 + wc * 32 + fq * 8) = pack8(v0, v1);
            }
    }
};
struct EpiM2 {
    static constexpr bool PERM = true;
    bf16_t* YB;
    __device__ __forceinline__ void operator()(const f32x4 (&acc)[2][2][4][2], const Unit& u, int wr, int wc, int fr, int fq) const {
#pragma unroll
        for (int ai = 0; ai < 2; ++ai)
#pragma unroll
            for (int m = 0; m < 4; ++m) {
                if (u.half >= 0 && u.half != ai) continue;
                const int row = u.pm * 256 + ai * 128 + wr * 64 + m * 16 + fr;
#pragma unroll
                for (int bj = 0; bj < 2; ++bj)
                    *(u32x4*)(YB + (size_t)row * 1024 + u.pn * 256 + bj * 128 + wc * 32 + fq * 8) = pack8(acc[ai][bj][m][0], acc[ai][bj][m][1]);
            }
    }
};
struct EpiIn1 {
    static constexpr bool PERM = true;
    bf16_t *Q1, *K1, *VT1, *ZHT;
    __device__ __forceinline__ void operator()(const f32x4 (&acc)[2][2][4][2], const Unit& u, int wr, int wc, int fr, int fq) const {
#pragma unroll
        for (int ai = 0; ai < 2; ++ai)
#pragma unroll
            for (int m = 0; m < 4; ++m) {
                if (u.half >= 0 && u.half != ai) continue;
                const int T = u.pm * 256 + ai * 128 + wr * 64 + m * 16 + fr;
#pragma unroll
                for (int bj = 0; bj < 2; ++bj) {
                    const int c = u.pn * 256 + bj * 128 + wc * 32 + fq * 8;
                    const f32x4 v0 = acc[ai][bj][m][0], v1 = acc[ai][bj][m][1];
                    if (u.pn < 2) { *(u32x4*)(Q1 + (size_t)(T - NCTX) * 512 + c) = pack8(v0, v1); }
                    else if (u.pn < 4) { *(u32x4*)(K1 + (size_t)T * 512 + (c - 512)) = pack8(v0, v1); }
                    else if (u.pn < 6) {
                        const int cc = c - 1024, h = cc >> 6, dh = cc & 63;
                        bf16_t* p;
                        if (T >= NCTX) { const int Tl = T - NCTX, b = Tl >> 13, pos = Tl & 8191; p = VT1 + ((size_t)(b * 8 + h) * 64 + dh) * 8192 + pos;
#pragma unroll
                            for (int j = 0; j < 4; ++j) { p[(size_t)j * 8192] = (bf16_t)f2bf(v0[j]); p[(size_t)(j + 4) * 8192] = (bf16_t)f2bf(v1[j]); } }
                        else { const int b = T >> 8, pos = T & 255; p = VT1 + (size_t)NB * 8 * 64 * 8192 + ((size_t)(b * 8 + h) * 64 + dh) * 256 + pos;
#pragma unroll
                            for (int j = 0; j < 4; ++j) { p[(size_t)j * 256] = (bf16_t)f2bf(v0[j]); p[(size_t)(j + 4) * 256] = (bf16_t)f2bf(v1[j]); } }
                    }
                    else {
                        bf16_t* p = ZHT + (size_t)(c - 1536) * NLAT + (T - NCTX);
#pragma unroll
                        for (int j = 0; j < 4; ++j) { p[(size_t)j * NLAT] = (bf16_t)f2bf(v0[j]); p[(size_t)(j + 4) * NLAT] = (bf16_t)f2bf(v1[j]); }
                    }
                }
            }
    }
};

struct SchedDense {
    g8::DenseOrder ord; const char* A; const char* Bt; size_t atile, btile; int pm_off;
    __device__ __forceinline__ bool next(int i, Unit& u) const {
        int L, pm, pn; if (!g8::tail_split(i, ord.G, ord.c, ord.nwg, L, u.half) || !ord.mapL(L, pm, pn)) return false;
        u.pm = pm + pm_off; u.pn = pn; u.aux = 0; u.rows = nullptr;
        u.a = A + (size_t)pm * atile; u.b = Bt + (size_t)pn * btile; return true;
    }
};
struct SchedIn1 {
    g8::DenseOrder ord; const char* A; const char* Bt; int G, c;
    __device__ __forceinline__ bool next(int i, Unit& u) const {
        int L, pm, pn; if (!g8::tail_split(i, G, c, ord.nwg + 16, L, u.half)) return false;
        if (L < ord.nwg) { ord.mapL(L, pm, pn); pm += 4; }
        else { const int Lc = L - ord.nwg; pm = Lc >> 2; pn = 2 + (Lc & 3); }
        u.pm = pm; u.pn = pn; u.aux = 0; u.rows = nullptr;
        u.a = A + (size_t)pm * 256 * 1024 * 2; u.b = Bt + (size_t)pn * 256 * 1024 * 2; return true;
    }
};
struct SchedS5 {
    const char* AS5; const char* Wt; int nN, K, G, c;
    __device__ __forceinline__ bool next(int i, Unit& u) const {
        int L; if (!g8::tail_split(i, G, c, 32 * 5 * nN, L, u.half)) return false;
        const int g = L / (5 * nN), rem = L % (5 * nN), pm = rem / nN, pn = rem % nN;
        u.pm = pm; u.pn = pn; u.aux = g; u.rows = nullptr;
        u.a = AS5 + ((size_t)g * S5ROWS + pm * 256) * S5K * 2;
        u.b = Wt + ((size_t)g * nN * 256 + pn * 256) * K * 2; return true;
    }
};
struct SchedMoe {
    const int* tiles; const int* tokbuf; const char* A; const char* W; size_t wexp, wtile, atile; int G, c, gather;
    __device__ __forceinline__ bool next(int i, Unit& u) const {
        const int nt = tiles[0]; int L; if (!g8::tail_split(i, G, c, nt * 4, L, u.half)) return false;
        const int tile = L >> 2, pn = L & 3, e = tiles[1 + tile];
        u.pm = tile; u.pn = pn; u.aux = e; u.rows = tokbuf + tile * 256;
        u.a = gather ? A : A + (size_t)tile * atile; u.b = W + (size_t)e * wexp + (size_t)pn * wtile; return true;
    }
};
#define XB_TMO      128
#define XB_XCNT(j)  (256  + 64 * (j))
#define XB_XSUB(j)  (1280 + 64 * (j))
#define XB_XGEN(j)  (2304 + 64 * (j))
#define XB_TOP      3328
#define XB_TOPGEN   3392
#define XCD_BAR_WORDS 3456
#define XB_SPIN_CAP (1u << 24)
__device__ __forceinline__ unsigned xb_ld(unsigned* p)              { return __hip_atomic_load(p, __ATOMIC_RELAXED, __HIP_MEMORY_SCOPE_AGENT); }
__device__ __forceinline__ unsigned xb_add(unsigned* p, unsigned v) { return __hip_atomic_fetch_add(p, v, __ATOMIC_RELAXED, __HIP_MEMORY_SCOPE_AGENT); }
__device__ __forceinline__ unsigned xb_xcc_id() { return (unsigned)__builtin_amdgcn_s_getreg((3 << 11) | 20) & 0xFu; }
#define XB_SPIN(cond, bar) do { unsigned _sp = 0; while (cond) { __builtin_amdgcn_s_sleep(1); \
    if ((++_sp & 255u) == 0u) { if (xb_ld(&(bar)[XB_TMO])) break; if (_sp > XB_SPIN_CAP) { atomicAdd(&(bar)[XB_TMO], 1u); break; } } } } while (0)
struct XcdBarrier { unsigned* bar; unsigned x; volatile LAS unsigned* st; };
__device__ __forceinline__ XcdBarrier xcd_barrier_post(unsigned* bar, volatile LAS unsigned* st) {
    XcdBarrier b; b.bar = bar; b.x = xb_xcc_id(); b.st = st;
    if (threadIdx.x == 0) (void)xb_add(&bar[XB_XCNT(b.x)], 1u);
    return b;
}
__device__ __forceinline__ void xcd_barrier_complete(unsigned* bar, unsigned x, unsigned& nloc, unsigned& nx) {
    const unsigned G = gridDim.x * gridDim.y * gridDim.z;
    unsigned sum, cnt, mine, sp = 0u;
    for (;;) {
        sum = 0u; cnt = 0u; mine = 0u;
#pragma unroll
        for (unsigned j = 0; j < 16; ++j) { const unsigned c = xb_ld(&bar[XB_XCNT(j)]); sum += c; cnt += (c > 0u) ? 1u : 0u; mine = (j == x) ? c : mine; }
        if (sum == G) break;
        __builtin_amdgcn_s_sleep(1);
        if ((++sp & 255u) == 0u) { if (xb_ld(&bar[XB_TMO])) break; if (sp > XB_SPIN_CAP) { atomicAdd(&bar[XB_TMO], 1u); break; } }
    }
    nloc = mine > 0u ? mine : 1u; nx = cnt > 0u ? cnt : 1u;
}
__device__ __forceinline__ void xcd_barrier(const XcdBarrier& b) {
    asm volatile("s_waitcnt vmcnt(0)" ::: "memory");
    __syncthreads();
    if (threadIdx.x == 0) {
        unsigned* bar = b.bar;
        __builtin_amdgcn_s_waitcnt(0);
        unsigned nloc = b.st[0], nx = b.st[1];
        if (nloc == 0u) { xcd_barrier_complete(bar, b.x, nloc, nx); b.st[0] = nloc; b.st[1] = nx; }
        const unsigned old = xb_add(&bar[XB_XSUB(b.x)], 1u);
        const unsigned gen = old / nloc;
        if (old + 1u == (gen + 1u) * nloc) {
            __builtin_amdgcn_fence(__ATOMIC_RELEASE, "agent");
            asm volatile("s_waitcnt vmcnt(0)" ::: "memory");
            const unsigned og = xb_add(&bar[XB_TOP], 1u);
            const unsigned tg = og / nx;
            if (og + 1u == (tg + 1u) * nx) xb_add(&bar[XB_TOPGEN], 1u);
            else XB_SPIN(xb_ld(&bar[XB_TOPGEN]) == tg, bar);
            __builtin_amdgcn_fence(__ATOMIC_ACQUIRE, "agent");
            xb_add(&bar[XB_XGEN(b.x)], 1u);
            asm volatile("s_waitcnt vmcnt(0)" ::: "memory");
        } else {
            XB_SPIN(xb_ld(&bar[XB_XGEN(b.x)]) == gen, bar);
            __builtin_amdgcn_fence(__ATOMIC_ACQUIRE, "agent");
            asm volatile("s_waitcnt vmcnt(0)" ::: "memory");
        }
    }
    __syncthreads();
}

constexpr int LDS_BYTES = 163840;
constexpr int LDSCTL_OFF = 163840 - 64;
struct Args { const float* in[43]; float* out; unsigned char* ws; int ph_lo, ph_hi, sub, li; };
enum { I_X = 0, I_C, I_CTX, I_CCTX, I_ADAW, I_ADAB, I_WG, I_BG, I_WE, I_BE, I_W1, I_W3, I_W2, I_EVIN, I_EVOUT, I_WA2, I_BA, I_GNORM,
       I_LAMRE, I_LAMIM, I_LOGDT, I_BRE, I_BIM, I_CRE, I_CIM, I_S5D, I_WGLU, I_ODIN, I_ODOUT, I_QN, I_KN, I_RPB, I_CONVW, I_CONVB,
       I_FW1, I_FB1, I_FW2, I_FB2, I_FW3, I_FB3, I_FREQ, I_FW4, I_HBIAS };

struct Frame {
    LAS unsigned char* lds;
    const Args* a;
    unsigned char* ws;
    int wave, G, bid;
};
#define FTID ((int)threadIdx.x)
#define FLANE ((int)(threadIdx.x & 63))
#define WSP(T, off) ((T*)(F.ws + (off)))

__device__ __forceinline__ void transpose_item(const float* W, int ldw, int col0, int K, bf16_t* WT, int row0, int kb, LAS float* scr, int lane, bool zero) {
    const int k0 = 64 * kb;
    if (!zero) {
        float wv[32];
#pragma unroll
        for (int i = 0; i < 32; ++i) { const int kk = 2 * i + (lane >> 5); wv[i] = W[(size_t)(k0 + kk) * ldw + col0 + (lane & 31)]; }
#pragma unroll
        for (int i = 0; i < 32; ++i) { const int kk = 2 * i + (lane >> 5); scr[kk * 33 + (lane & 31)] = wv[i]; }
    }
    LDS_WAIT(); asm volatile("" ::: "memory");
    const int c = lane & 7;
#pragma unroll
    for (int j = 0; j < 4; ++j) { const int n = (lane >> 3) + 8 * j; const LAS float* s = scr + (8 * c) * 33 + n;
        u32x4 o;
        if (zero) { o = (u32x4){0u, 0u, 0u, 0u}; }
        else { o.x = pk2(s[0 * 33], s[1 * 33]); o.y = pk2(s[2 * 33], s[3 * 33]); o.z = pk2(s[4 * 33], s[5 * 33]); o.w = pk2(s[6 * 33], s[7 * 33]); }
        *(u32x4*)(WT + (size_t)(row0 + n) * K + k0 + 8 * c) = o; }
    LDS_WAIT(); asm volatile("" ::: "memory");
}
__device__ __forceinline__ void moe_conv_item(const Frame& F, int layer, int it, LAS float* scr) {
    const int e = it / 768, r = it % 768;
    if (r < 512) {
        const int kb = r >> 5, nb = r & 31, drow = nb * 32;
        const int pn = drow >> 8, within = drow & 255, isw3 = within >> 7, col = pn * 128 + (within & 127);
        const float* W = F.a->in[isw3 ? I_W3 : I_W1] + ((size_t)layer * NEXP + e) * 1024 * 512;
        transpose_item(W, 512, col, 1024, WSP(bf16_t, W_M13) + (size_t)e * 1024 * 1024, drow, kb, scr, FLANE, false);
    } else {
        const int rr = r - 512, kb = rr >> 5, nb = rr & 31;
        const float* W = F.a->in[I_W2] + ((size_t)layer * NEXP + e) * 512 * 1024;
        transpose_item(W, 1024, nb * 32, 512, WSP(bf16_t, W_M2) + (size_t)e * 1024 * 512, nb * 32, kb, scr, FLANE, false);
    }
}
__device__ __forceinline__ void small_conv_item(const Frame& F, int it, LAS float* scr) {
    if (it < 1024) {
        const int kb = it >> 6, nb = it & 63, drow = nb * 32;
        const int col = drow < 1536 ? drow : drow + 32;
        transpose_item(F.a->in[I_EVIN], 2080, col, 1024, WSP(bf16_t, W_IN0), drow, kb, scr, FLANE, false); return; }
    it -= 1024;
    if (it < 512) { transpose_item(F.a->in[I_EVOUT], 1024, (it & 31) * 32, 1024, WSP(bf16_t, W_OUT0), (it & 31) * 32, it >> 5, scr, FLANE, false); return; }
    it -= 512;
    if (it < 128) { transpose_item(F.a->in[I_WGLU], 512, (it & 15) * 32, 512, WSP(bf16_t, W_GLU), (it & 15) * 32, it >> 4, scr, FLANE, false); return; }
    it -= 128;
    if (it < 1536) { transpose_item(F.a->in[I_ODIN], 3072, (it % 96) * 32, 1024, WSP(bf16_t, W_IN1), (it % 96) * 32, it / 96, scr, FLANE, false); return; }
    it -= 1536;
    transpose_item(F.a->in[I_ODOUT], 1024, (it & 31) * 32, 1024, WSP(bf16_t, W_OUT1), (it & 31) * 32, it >> 5, scr, FLANE, false);
}
constexpr int SMALL_ITEMS = 1024 + 512 + 128 + 1536 + 512;
__device__ __forceinline__ void fold_la_weights(const Frame& F) {
    const float* win = F.a->in[I_EVIN]; const float* wa2 = F.a->in[I_WA2]; bf16_t* WT = WSP(bf16_t, W_IN0) + (size_t)2048 * 1024;
    for (int i = F.bid * 512 + FTID; i < 512 * 1024; i += F.G * 512) {
        const int k = i & 1023, n = i >> 10, d = n >> 8, c = n & 255;
        const float* a = win + (size_t)k * 2080 + 1536 + 16 * d; float s = 0.f;
#pragma unroll
        for (int r = 0; r < 16; ++r) s += a[r] * wa2[(d * 16 + r) * 256 + c];
        WT[(size_t)n * 1024 + k] = (bf16_t)f2bf(s);
    }
}
constexpr int MOE_ITEMS = 32 * 768;

__device__ __forceinline__ void mod_item(const Frame& F, int it, const LAS float* sc  , LAS float* part  ) {
    const int layer = it / 96, cb = it % 96, col = cb * 64 + FLANE, w = F.wave;
    const float* W = F.a->in[I_ADAW] + (size_t)layer * 1024 * 6144 + (size_t)(128 * w) * 6144 + col;
    float acc[5] = {0.f, 0.f, 0.f, 0.f, 0.f};
#pragma unroll 8
    for (int k = 0; k < 128; ++k) { const float wv = W[(size_t)k * 6144];
#pragma unroll
        for (int v = 0; v < 5; ++v) acc[v] += sc[v * 1024 + 128 * w + k] * wv; }
    __syncthreads();
#pragma unroll
    for (int v = 0; v < 5; ++v) part[(w * 5 + v) * 64 + FLANE] = acc[v];
    __syncthreads();
    if (FTID < 320) { const int v = FTID >> 6, l = FTID & 63; float s = 0.f;
#pragma unroll
        for (int ww = 0; ww < 8; ++ww) s += part[(ww * 5 + v) * 64 + l];
        WSP(float, M_MOD)[(layer * 5 + v) * 6144 + cb * 64 + l] = s + F.a->in[I_ADAB][layer * 6144 + cb * 64 + l]; }
}

__device__ __forceinline__ void hy_hidden_items(const Frame& F, int t_first, int t_step) {
    const float* fw1 = F.a->in[I_FW1]; const float* fw2 = F.a->in[I_FW2]; const float* fw3 = F.a->in[I_FW3];
    const int j = FLANE; const float fr = F.a->in[I_FREQ][j];
    float w2[64], w3[64];
#pragma unroll
    for (int i = 0; i < 64; ++i) { w2[i] = fw2[i * 64 + j]; w3[i] = fw3[i * 64 + j]; }
    const float b1 = F.a->in[I_FB1][j], b2 = F.a->in[I_FB2][j], b3 = F.a->in[I_FB3][j];
#pragma unroll 1
    for (int t = t_first; t < 8192; t += t_step) {
        float feat = 0.f;
        {
            const float w = 6.283185307179586f * (float)t / 8192.f;
            if (j == 0) feat = (float)t / 8191.f;
            else if (j < 33) { const int k = (j - 1) & 15; const float f = 1e-4f + (float)k * ((15.f - 1e-4f) / 15.f); float s, c; sincosf(f * w, &s, &c); feat = (j < 17) ? c : -s; }
        }
        float a1 = b1;
#pragma unroll
        for (int i = 0; i < 33; ++i) a1 += __builtin_bit_cast(float, __builtin_amdgcn_readlane(__builtin_bit_cast(int, feat), i)) * fw1[i * 64 + j];
        const float h1 = sinf(fr * a1);
        float a2 = b2;
#pragma unroll
        for (int i = 0; i < 64; ++i) a2 += __builtin_bit_cast(float, __builtin_amdgcn_readlane(__builtin_bit_cast(int, h1), i)) * w2[i];
        const float h2 = sinf(fr * a2);
        float a3 = b3;
#pragma unroll
        for (int i = 0; i < 64; ++i) a3 += __builtin_bit_cast(float, __builtin_amdgcn_readlane(__builtin_bit_cast(int, h2), i)) * w3[i];
        WSP(float, M_H3)[t * 64 + j] = sinf(fr * a3);
    }
}
__device__ __forceinline__ void s5_tables(const Frame& F, int g, LAS f32x2* Cc, LAS f32x2* Bb, LAS f32x2* AP) {
    const int tid = FTID;
    const float* lam_re = F.a->in[I_LAMRE]; const float* lam_im = F.a->in[I_LAMIM]; const float* log_dt = F.a->in[I_LOGDT];
    const float* b_re = F.a->in[I_BRE]; const float* b_im = F.a->in[I_BIM]; const float* c_re = F.a->in[I_CRE]; const float* c_im = F.a->in[I_CIM];
    __syncthreads();
    for (int i = tid; i < 2 * 64 * 33; i += 512) {
        const int e = i % 33, dp = i / 33, d = dp >> 6, p = dp & 63, gp = (d * 32 + g) * 64 + p;
        const float dt = __expf(log_dt[d * 32 + g]);
        const float mag = expf(lam_re[gp] * dt * (float)e); float s, c; sincosf(lam_im[gp] * dt * (float)e, &s, &c); AP[i] = (f32x2){mag * c, mag * s};
    }
    for (int i = tid; i < 2 * 64 * 16; i += 512) {
        const int h = i & 15, dp = i >> 4, d = dp >> 6, p = dp & 63, gp = (d * 32 + g) * 64 + p;
        const float lr = lam_re[gp], li = lam_im[gp], dt = __expf(log_dt[d * 32 + g]);
        const float mag = expf(lr * dt); float s, c; sincosf(li * dt, &s, &c);
        const float ar = mag * c, ai = mag * s, den = lr * lr + li * li, nr = ar - 1.f;
        const float cor = (nr * lr + ai * li) / den, coi = (ai * lr - nr * li) / den;
        const float br = b_re[(size_t)gp * 16 + h], bi = b_im[(size_t)gp * 16 + h]; Bb[i] = (f32x2){cor * br - coi * bi, cor * bi + coi * br};
    }
    for (int i = tid; i < 2 * 16 * 64; i += 512) { const int d = i >> 10, hp = (i >> 6) & 15, p = i & 63; const size_t gi = ((size_t)(d * 32 + g) * 16 + hp) * 64 + p; Cc[i] = (f32x2){c_re[gi], c_im[gi]}; }
    __syncthreads();
}
__device__ __forceinline__ void s5_kern_part(const Frame& F, int g, int part) {
    LAS f32x2* Cc = (LAS f32x2*)F.lds; LAS f32x2* Bb = Cc + 2 * 16 * 64; LAS f32x2* AP = Bb + 2 * 64 * 16;
    s5_tables(F, g, Cc, Bb, AP);
    const int tid = FTID, d = tid >> 8, hp = (tid >> 4) & 15, h = tid & 15;
    float* KG = WSP(float, M_KERN) + (size_t)g * 2 * 32 * 256;
#pragma unroll 1
    for (int tau = 4 * part; tau < 4 * part + 4; ++tau) {
        float acc = 0.f;
#pragma unroll 4
        for (int p = 0; p < 64; ++p) {
            const f32x2 c = Cc[(d * 16 + hp) * 64 + p], a = AP[(d * 64 + p) * 33 + tau], b = Bb[(d * 64 + p) * 16 + h];
            const float cr = c.x * a.x - c.y * a.y, ci = c.x * a.y + c.y * a.x;
            acc += cr * b.x - ci * b.y;
        }
        KG[((d * 32 + tau) * 16 + hp) * 16 + h] = acc;
    }
    __syncthreads();
}
__device__ __forceinline__ void s5_fill_part(const Frame& F, int g, int part) {
    LAS f32x2* Cc = (LAS f32x2*)F.lds; LAS f32x2* Bb = Cc + 2 * 16 * 64; LAS f32x2* AP = Bb + 2 * 64 * 16; LAS float* KERN = (LAS float*)(AP + 2 * 64 * 33);
    s5_tables(F, g, Cc, Bb, AP);
    const int tid = FTID;
    { const f32x4* KG = (const f32x4*)(WSP(float, M_KERN) + (size_t)g * 2 * 32 * 256); f32x4 kv[8];
#pragma unroll
      for (int q = 0; q < 8; ++q) kv[q] = KG[tid + 512 * q];
#pragma unroll
      for (int q = 0; q < 8; ++q) ((LAS f32x4*)KERN)[tid + 512 * q] = kv[q]; }
    __syncthreads();
    const float* dsk = F.a->in[I_S5D] + g * 16;
    bf16_t* W3 = WSP(bf16_t, W_S3) + (size_t)g * 512 * S5K;
    bf16_t* W1 = WSP(bf16_t, W_S1) + (size_t)g * 256 * S5KU;
    for (int i = tid; i < 64 * (S5K / 8); i += 512) {
        const int n = 64 * part + i / (S5K / 8), k0 = (i % (S5K / 8)) * 8, t = n >> 4, hp = n & 15;
        float v[8];
        if (k0 < S5KU) {
            const int s = k0 >> 4, h0 = k0 & 15;
#pragma unroll
            for (int e = 0; e < 8; ++e) { float val = 0.f;
                if (s <= t) val += KERN[((0 * 32 + (t - s)) * 16 + hp) * 16 + h0 + e];
                if (s >= t) val += KERN[((1 * 32 + (s - t)) * 16 + hp) * 16 + h0 + e];
                if (s == t && h0 + e == hp) val += dsk[hp];
                v[e] = val; }
        } else {
            const int kk = k0 - S5KU, d = kk >> 7, pt = (kk >> 6) & 1, p0 = kk & 63, ex = d == 0 ? t + 1 : S5TC - t;
#pragma unroll
            for (int e = 0; e < 8; ++e) { const f32x2 c = Cc[(d * 16 + hp) * 64 + p0 + e], a = AP[(d * 64 + p0 + e) * 33 + ex];
                v[e] = pt == 0 ? (c.x * a.x - c.y * a.y) : -(c.x * a.y + c.y * a.x); }
        }
        *(u32x4*)(W3 + (size_t)n * S5K + k0) = (u32x4){pk2(v[0], v[1]), pk2(v[2], v[3]), pk2(v[4], v[5]), pk2(v[6], v[7])};
    }
    for (int i = tid; i < 32 * (S5KU / 8); i += 512) {
        const int n = 32 * part + i / (S5KU / 8), k0 = (i % (S5KU / 8)) * 8, d = n >> 7, pt = (n >> 6) & 1, p = n & 63;
        const int s = k0 >> 4, h0 = k0 & 15, ex = d == 0 ? S5TC - 1 - s : s;
        const f32x2 a = AP[(d * 64 + p) * 33 + ex];
        float v[8];
#pragma unroll
        for (int e = 0; e < 8; ++e) { const f32x2 b = Bb[(d * 64 + p) * 16 + h0 + e]; v[e] = pt == 0 ? (a.x * b.x - a.y * b.y) : (a.x * b.y + a.y * b.x); }
        *(u32x4*)(W1 + (size_t)n * S5KU + k0) = (u32x4){pk2(v[0], v[1]), pk2(v[2], v[3]), pk2(v[4], v[5]), pk2(v[6], v[7])};
    }
    __syncthreads();
}

__device__ __forceinline__ void phase0(const Frame& F) {
    const int gw = F.bid * 8 + F.wave, NGW = F.G * 8;
    for (int u = F.bid; u < 256; u += F.G) s5_kern_part(F, u >> 3, u & 7);
    LAS float* sc = (LAS float*)(F.lds + 8 * 16384);
    __syncthreads();
    for (int i = FTID; i < 5 * 1024; i += 512) { const int v = i >> 10, k = i & 1023; const float x = v < 4 ? F.a->in[I_C][v * 1024 + k] : F.a->in[I_CCTX][k]; sc[i] = silu_f(x); }
    __syncthreads();
    for (int it = F.bid; it < 192; it += F.G) mod_item(F, it, sc, (LAS float*)(F.lds + 8 * 16384 + 5 * 4096));
    for (int i = F.bid * 512 + FTID; i < FFTN; i += F.G * 512) { float s, c; sincospif((float)i * (1.0f / 8192.f), &s, &c); WSP(f32x2, M_TW)[i] = (f32x2){c, -s}; }
    for (int i = F.bid * 512 + FTID; i < 128 * 16; i += F.G * 512) { const int pos = i >> 4, j = i & 15; const float fq = powf(10000.f, -(float)j / 16.f); float s, c; sincosf((float)pos * fq, &s, &c); WSP(f32x2, M_ROPE)[i] = (f32x2){c, s}; }
    hy_hidden_items(F, gw, NGW);
    LAS float* scr = (LAS float*)(F.lds + F.wave * 16384);
    fold_la_weights(F);
    for (int it = gw; it < SMALL_ITEMS; it += NGW) small_conv_item(F, it, scr);
}

__device__ __forceinline__ void norm_mod_row(const float* xrow, const float* shift, const float* scale, bf16_t* orow, int lane) {
    const f32x4* xr = (const f32x4*)xrow + lane;
    f32x4 v[4]; float s = 0.f;
#pragma unroll
    for (int j = 0; j < 4; ++j) { v[j] = xr[64 * j]; s += (v[j].x * v[j].x + v[j].y * v[j].y) + (v[j].z * v[j].z + v[j].w * v[j].w); }
    const float rinv = rsqrtf(wave_sum(s) * (1.f / 1024.f) + EPS);
    unsigned long long* o8 = (unsigned long long*)orow + lane;
#pragma unroll
    for (int j = 0; j < 4; ++j) {
        const f32x4 sh = ((const f32x4*)shift)[lane + 64 * j], sl = ((const f32x4*)scale)[lane + 64 * j];
        const f32x4 h = v[j] * rinv * (sl + 1.f) + sh;
        o8[64 * j] = (unsigned long long)pk2(h.x, h.y) | ((unsigned long long)pk2(h.z, h.w) << 32);
    }
}
__device__ __forceinline__ void phase1_norm0(const Frame& F) {
    for (int u = F.bid; u < 256; u += F.G) s5_fill_part(F, u >> 3, u & 7);
    const int gw = F.bid * 8 + F.wave, NGW = F.G * 8;
    const float* mod = WSP(float, M_MOD);
    const int lane = FLANE;
    for (int T = gw; T < NTOK; T += 2 * NGW) {
        const int T2 = T + NGW; const bool has2 = T2 < NTOK; const int Tb = has2 ? T2 : T;
        const float* xa = T < NCTX ? F.a->in[I_CTX] + (size_t)T * 1024 : F.a->in[I_X] + (size_t)(T - NCTX) * 1024;
        const float* xb = Tb < NCTX ? F.a->in[I_CTX] + (size_t)Tb * 1024 : F.a->in[I_X] + (size_t)(Tb - NCTX) * 1024;
        f32x4 va[4], vb[4]; float sa = 0.f, sb = 0.f;
#pragma unroll
        for (int j = 0; j < 4; ++j) { va[j] = ((const f32x4*)xa)[lane + 64 * j]; vb[j] = ((const f32x4*)xb)[lane + 64 * j]; }
#pragma unroll
        for (int j = 0; j < 4; ++j) { sa += (va[j].x * va[j].x + va[j].y * va[j].y) + (va[j].z * va[j].z + va[j].w * va[j].w); sb += (vb[j].x * vb[j].x + vb[j].y * vb[j].y) + (vb[j].z * vb[j].z + vb[j].w * vb[j].w); }
        const float ra = rsqrtf(wave_sum(sa) * (1.f / 1024.f) + EPS), rb = rsqrtf(wave_sum(sb) * (1.f / 1024.f) + EPS);
        const float* ma = mod + tok_b5(T) * 6144; const float* mb = mod + tok_b5(Tb) * 6144;
        unsigned long long* oa = (unsigned long long*)(WSP(bf16_t, B_ABUF) + (size_t)T * 1024) + lane;
        unsigned long long* ob = (unsigned long long*)(WSP(bf16_t, B_ABUF) + (size_t)Tb * 1024) + lane;
#pragma unroll
        for (int j = 0; j < 4; ++j) {
            const f32x4 ha = va[j] * ra * (((const f32x4*)(ma + 1024))[lane + 64 * j] + 1.f) + ((const f32x4*)ma)[lane + 64 * j];
            oa[64 * j] = (unsigned long long)pk2(ha.x, ha.y) | ((unsigned long long)pk2(ha.z, ha.w) << 32);
            if (has2) { const f32x4 hb = vb[j] * rb * (((const f32x4*)(mb + 1024))[lane + 64 * j] + 1.f) + ((const f32x4*)mb)[lane + 64 * j];
                ob[64 * j] = (unsigned long long)pk2(hb.x, hb.y) | ((unsigned long long)pk2(hb.z, hb.w) << 32); }
        }
    }
}
__device__ __forceinline__ void gla_chunk_info(int ch, int d, int& b, int& c, bool& lat, int& slot) {
    lat = ch >= 16;
    if (!lat) { b = ch >> 2; c = ch & 3; slot = d == 0 ? c : 3 - c; }
    else { b = (ch - 16) >> 7; c = (ch - 16) & 127; slot = d == 0 ? 4 + c : 4 + 127 - c; }
}
constexpr int GP = 72;

#define dpp_f(v, ctrl, row_mask, bc) __builtin_bit_cast(float, __builtin_amdgcn_update_dpp(0, __builtin_bit_cast(int, (v)), (ctrl), (row_mask), 0xF, (bc)))
__device__ __forceinline__ float wave_prefix_incl(float v) {
    v += dpp_f(v, 0x111, 0xF, true);
    v += dpp_f(v, 0x112, 0xF, true);
    v += dpp_f(v, 0x114, 0xF, true);
    v += dpp_f(v, 0x118, 0xF, true);
    v += dpp_f(v, 0x142, 0xA, false);
    v += dpp_f(v, 0x143, 0xC, false);
    return v;
}
__device__ __forceinline__ void unpack8(const u32x4 r, float* o) {
    o[0] = bf2f(r.x & 0xffffu); o[1] = bf2f(r.x >> 16); o[2] = bf2f(r.y & 0xffffu); o[3] = bf2f(r.y >> 16);
    o[4] = bf2f(r.z & 0xffffu); o[5] = bf2f(r.z >> 16); o[6] = bf2f(r.w & 0xffffu); o[7] = bf2f(r.w >> 16);
}
__device__ __forceinline__ void gla_c1_unit(const Frame& F, int ch) {
    LAS float* decs = (LAS float*)(F.lds + 8 * 64 * GP * 2) + F.wave * 64;
    LAS bf16_t* ket = (LAS bf16_t*)(F.lds + F.wave * 64 * GP * 2);
    const int h = F.wave >> 1, d = F.wave & 1, lane = FLANE, fr = lane & 15, fq = lane >> 4;
    int b, c; bool lat; int slot; gla_chunk_info(ch, d, b, c, lat, slot);
    {
        const size_t T = (size_t)ch * 64 + lane;
        const u32x4* kp = (const u32x4*)(WSP(bf16_t, B_QK) + T * 512 + 256 + h * 64);
        const u32x4* lp = (const u32x4*)(WSP(bf16_t, B_LA) + T * 512 + d * 256 + h * 64);
        u32x4 kr[8], lr[8];
#pragma unroll
        for (int q = 0; q < 8; ++q) { kr[q] = kp[q]; lr[q] = lp[q]; }
        float kf[64], lf[64];
#pragma unroll
        for (int q = 0; q < 8; ++q) { unpack8(kr[q], kf + 8 * q); unpack8(lr[q], lf + 8 * q); }
        if (lat) {
            const f32x2* rope = WSP(f32x2, M_ROPE);
#pragma unroll
            for (int j = 0; j < 16; ++j) {
                const f32x2 cr = rope[c * 16 + j], cc = rope[lane * 16 + j];
                const float a1 = kf[j], a2 = kf[16 + j], b1 = kf[32 + j], b2 = kf[48 + j];
                kf[j] = a1 * cr.x - a2 * cr.y; kf[16 + j] = a1 * cr.y + a2 * cr.x;
                kf[32 + j] = b1 * cc.x - b2 * cc.y; kf[48 + j] = b1 * cc.y + b2 * cc.x;
            }
        }
        float mytot = 0.f;
#pragma unroll
        for (int i = 0; i < 64; ++i) {
            const float la = lf[i], pre = wave_prefix_incl(la);
            const float total = __builtin_bit_cast(float, __builtin_amdgcn_readlane(__builtin_bit_cast(int, pre), 63));
            const float bcum = d == 0 ? pre : total - pre + la;
            ket[i * GP + lane] = (bf16_t)f2bf(kf[i] * __expf(-bcum));
            mytot = lane == i ? total : mytot;
        }
        const float dec = __expf(mytot);
        decs[lane] = dec;
        WSP(float, B_DEC)[((size_t)((b * 2 + d) * GSEQ + slot) * 4 + h) * 64 + lane] = dec;
    }
    LDS_WAIT(); asm volatile("" ::: "memory");
    const bf16_t* vt = WSP(bf16_t, B_VT) + (size_t)(ch * 4 + h) * 128 * 64;
    bf16_t* upd = WSP(bf16_t, B_UPD) + ((size_t)((b * 2 + d) * GSEQ + slot) * 4 + h) * 128 * 64;
    bf16x8 Af[4][2];
#pragma unroll
    for (int rt = 0; rt < 4; ++rt)
#pragma unroll
        for (int ks = 0; ks < 2; ++ks) Af[rt][ks] = *(const LAS bf16x8*)(ket + (16 * rt + fr) * GP + 32 * ks + 8 * fq);
#pragma unroll
    for (int ct = 0; ct < 8; ++ct) {
        bf16x8 Bf[2];
#pragma unroll
        for (int ks = 0; ks < 2; ++ks) Bf[ks] = *(const bf16x8*)(vt + (size_t)(16 * ct + fr) * 64 + 32 * ks + 8 * fq);
#pragma unroll
        for (int rt = 0; rt < 4; ++rt) {
            f32x4 a4 = (f32x4){0.f, 0.f, 0.f, 0.f};
            a4 = __builtin_amdgcn_mfma_f32_16x16x32_bf16(Af[rt][0], Bf[0], a4, 0, 0, 0);
            a4 = __builtin_amdgcn_mfma_f32_16x16x32_bf16(Af[rt][1], Bf[1], a4, 0, 0, 0);
            const f32x4 dd = *(const LAS f32x4*)(decs + 16 * rt + 4 * fq);
            u32x2 w; w.x = pk2(a4[0] * dd[0], a4[1] * dd[1]); w.y = pk2(a4[2] * dd[2], a4[3] * dd[3]);
            *(u32x2*)(upd + (size_t)(16 * ct + fr) * 64 + 16 * rt + 4 * fq) = w;
        }
    }
    LDS_WAIT(); asm volatile("" ::: "memory");
}

__device__ __forceinline__ void gla_scan(const Frame& F) {
    for (int idx = F.bid * 512 + FTID; idx < 131072; idx += F.G * 512) {
        const int kp = idx & 31, dv = (idx >> 5) & 127, h = (idx >> 12) & 3, bd = idx >> 14;
        unsigned* u = WSP(unsigned, B_UPD) + ((size_t)(bd * GSEQ * 4 + h) * 128 + dv) * 32 + kp;
        const f32x2* dc = WSP(f32x2, B_DEC) + ((size_t)(bd * GSEQ * 4 + h) * 32 + kp);
        float s0 = 0.f, s1 = 0.f;
        for (int s = 0; s < GSEQ; s += 22) {
            unsigned uu[22]; f32x2 dd[22];
#pragma unroll
            for (int q = 0; q < 22; ++q) { uu[q] = u[(size_t)(s + q) * (4 * 128 * 32)]; dd[q] = dc[(size_t)(s + q) * (4 * 32)]; }
#pragma unroll
            for (int q = 0; q < 22; ++q) {
                u[(size_t)(s + q) * (4 * 128 * 32)] = pk2(s0, s1);
                s0 = dd[q].x * s0 + bf2f(uu[q] & 0xffffu); s1 = dd[q].y * s1 + bf2f(uu[q] >> 16);
            }
        }
    }
}

__device__ __forceinline__ void gla_c3_unit(const Frame& F, int ch, int var) {
    const int h = F.wave >> 1, hf = F.wave & 1, lane = FLANE, fr = lane & 15, fq = lane >> 4;
    LAS bf16_t* qe = (LAS bf16_t*)(F.lds + h * 2 * 64 * GP * 2);
    LAS bf16_t* ke = qe + 64 * GP;
    LAS float* tot = (LAS float*)(F.lds + 4 * 2 * 64 * GP * 2);
    __syncthreads();
    f32x4 acc[4][4];
#pragma unroll
    for (int dt = 0; dt < 4; ++dt)
#pragma unroll
        for (int ti = 0; ti < 4; ++ti) acc[dt][ti] = (f32x4){0.f, 0.f, 0.f, 0.f};
    const bf16_t* vt = WSP(bf16_t, B_VT) + ((size_t)(ch * 4 + h) * 128 + 64 * hf) * 64;
#pragma unroll 1
    for (int d = 0; d < 2; ++d) {
        int b, c; bool lat; int slot; gla_chunk_info(ch, d, b, c, lat, slot);
        const bf16_t* sb = WSP(bf16_t, B_UPD) + (((size_t)((b * 2 + d) * GSEQ + slot) * 4 + h) * 128 + 64 * hf) * 64;
        if (var != 1) {
            const size_t T = (size_t)ch * 64 + lane;
            const u32x4* qp = (const u32x4*)(WSP(bf16_t, B_QK) + T * 512 + h * 64 + 32 * hf);
            const u32x4* kp = (const u32x4*)(WSP(bf16_t, B_QK) + T * 512 + 256 + h * 64 + 32 * hf);
            const u32x4* lp = (const u32x4*)(WSP(bf16_t, B_LA) + T * 512 + d * 256 + h * 64 + 32 * hf);
            u32x4 qr[4], kr[4], lr[4];
#pragma unroll
            for (int q = 0; q < 4; ++q) { qr[q] = qp[q]; kr[q] = kp[q]; lr[q] = lp[q]; }
            float qf[32], kf[32], lf[32];
#pragma unroll
            for (int q = 0; q < 4; ++q) { unpack8(qr[q], qf + 8 * q); unpack8(kr[q], kf + 8 * q); unpack8(lr[q], lf + 8 * q); }
            if (lat) {
                const f32x2* rope = WSP(f32x2, M_ROPE) + (hf == 0 ? c : lane) * 16;
#pragma unroll
                for (int j = 0; j < 16; ++j) {
                    const f32x2 cs = rope[j];
                    const float q1 = qf[j], q2 = qf[16 + j], k1 = kf[j], k2 = kf[16 + j];
                    qf[j] = q1 * cs.x - q2 * cs.y; qf[16 + j] = q1 * cs.y + q2 * cs.x;
                    kf[j] = k1 * cs.x - k2 * cs.y; kf[16 + j] = k1 * cs.y + k2 * cs.x;
                }
            }
            u32x4 qo[4], ko[4];
#pragma unroll
            for (int q = 0; q < 4; ++q) {
                float qe8[8], ke8[8];
#pragma unroll
                for (int e = 0; e < 8; ++e) {
                    const int i = 8 * q + e;
                    const float la = lf[i], pre = wave_prefix_incl(la);
                    const float total = __builtin_bit_cast(float, __builtin_amdgcn_readlane(__builtin_bit_cast(int, pre), 63));
                    const float bcum = d == 0 ? pre : total - pre + la;
                    qe8[e] = qf[i] * __expf(bcum) * 0.125f; ke8[e] = kf[i] * __expf(-bcum);
                }
                qo[q].x = pk2(qe8[0], qe8[1]); qo[q].y = pk2(qe8[2], qe8[3]); qo[q].z = pk2(qe8[4], qe8[5]); qo[q].w = pk2(qe8[6], qe8[7]);
                ko[q].x = pk2(ke8[0], ke8[1]); ko[q].y = pk2(ke8[2], ke8[3]); ko[q].z = pk2(ke8[4], ke8[5]); ko[q].w = pk2(ke8[6], ke8[7]);
            }
            if (d == 1) __syncthreads();
#pragma unroll
            for (int q = 0; q < 4; ++q) { *(LAS u32x4*)(qe + lane * GP + 32 * hf + 8 * q) = qo[q]; *(LAS u32x4*)(ke + lane * GP + 32 * hf + 8 * q) = ko[q]; }
        }
        bf16x8 Av[4][2], As[4][2];
#pragma unroll
        for (int dt = 0; dt < 4; ++dt)
#pragma unroll
            for (int ksp = 0; ksp < 2; ++ksp) {
                const bf16_t* vr = vt + (size_t)(16 * dt + fr) * 64 + 32 * ksp + 4 * fq;
                const u32x2 lo = *(const u32x2*)vr, hi = *(const u32x2*)(vr + 16);
                Av[dt][ksp] = __builtin_bit_cast(bf16x8, (u32x4){lo.x, lo.y, hi.x, hi.y});
                As[dt][ksp] = *(const bf16x8*)(sb + (size_t)(16 * dt + fr) * 64 + 32 * ksp + 8 * fq);
            }
        __syncthreads();
        if (var != 2)
#pragma unroll
        for (int tih = 0; tih < 2; ++tih) {
            bf16x8 Bq[2][2], P[2][2];
#pragma unroll
            for (int t2 = 0; t2 < 2; ++t2)
#pragma unroll
                for (int ks = 0; ks < 2; ++ks) Bq[t2][ks] = *(const LAS bf16x8*)(qe + (16 * (2 * tih + t2) + fr) * GP + 32 * ks + 8 * fq);
#pragma unroll
            for (int t2 = 0; t2 < 2; ++t2) {
                const int ti = 2 * tih + t2, tI = 16 * ti + fr;
#pragma unroll
                for (int ksp = 0; ksp < 2; ++ksp) {
                    f32x4 s2[2];
#pragma unroll
                    for (int x = 0; x < 2; ++x) {
                        const int tj = 2 * ksp + x;
                        const bf16x8 A0 = *(const LAS bf16x8*)(ke + (16 * tj + fr) * GP + 8 * fq), A1 = *(const LAS bf16x8*)(ke + (16 * tj + fr) * GP + 32 + 8 * fq);
                        f32x4 a4 = (f32x4){0.f, 0.f, 0.f, 0.f};
                        a4 = __builtin_amdgcn_mfma_f32_16x16x32_bf16(A0, Bq[t2][0], a4, 0, 0, 0);
                        a4 = __builtin_amdgcn_mfma_f32_16x16x32_bf16(A1, Bq[t2][1], a4, 0, 0, 0);
#pragma unroll
                        for (int i = 0; i < 4; ++i) { const int tJ = 16 * tj + 4 * fq + i; const bool keep = d == 0 ? (tJ <= tI) : (tJ > tI); a4[i] = keep ? a4[i] : 0.f; }
                        s2[x] = a4;
                    }
                    const u32x4 w = pack8(s2[0], s2[1]);
                    P[t2][ksp] = __builtin_bit_cast(bf16x8, w);
                }
            }
#pragma unroll
            for (int dt = 0; dt < 4; ++dt) {
#pragma unroll
                for (int t2 = 0; t2 < 2; ++t2) {
                    f32x4 a4 = acc[dt][2 * tih + t2];
                    a4 = __builtin_amdgcn_mfma_f32_16x16x32_bf16(Av[dt][0], P[t2][0], a4, 0, 0, 0);
                    a4 = __builtin_amdgcn_mfma_f32_16x16x32_bf16(Av[dt][1], P[t2][1], a4, 0, 0, 0);
                    a4 = __builtin_amdgcn_mfma_f32_16x16x32_bf16(As[dt][0], Bq[t2][0], a4, 0, 0, 0);
                    a4 = __builtin_amdgcn_mfma_f32_16x16x32_bf16(As[dt][1], Bq[t2][1], a4, 0, 0, 0);
                    acc[dt][2 * tih + t2] = a4;
                }
            }
            __builtin_amdgcn_sched_barrier(0);
        }
    }
    float ssv[4];
#pragma unroll
    for (int ti = 0; ti < 4; ++ti) {
        float ss = 0.f;
#pragma unroll
        for (int dt = 0; dt < 4; ++dt) { const f32x4 v = acc[dt][ti]; ss += (v[0] * v[0] + v[1] * v[1]) + (v[2] * v[2] + v[3] * v[3]); }
        ss += __shfl_xor(ss, 16); ss += __shfl_xor(ss, 32);
        ssv[ti] = ss;
    }
    __syncthreads();
    if (fq == 0) {
#pragma unroll
        for (int ti = 0; ti < 4; ++ti) tot[(h * 2 + hf) * 64 + 16 * ti + fr] = ssv[ti];
    }
    __syncthreads();
    const float* gn = F.a->in[I_GNORM];
#pragma unroll
    for (int ti = 0; ti < 4; ++ti) {
        const float ss = ssv[ti] + tot[(h * 2 + (hf ^ 1)) * 64 + 16 * ti + fr];
        const float rinv = rsqrtf(ss * (1.f / 128.f) + EPS);
        const int T = ch * 64 + 16 * ti + fr;
        const bf16_t* gp = WSP(bf16_t, B_G) + (size_t)T * 512 + h * 128 + 64 * hf + 4 * fq;
        bf16_t* op = WSP(bf16_t, B_MIX0) + (size_t)T * 1024 + h * 128 + 64 * hf + 4 * fq;
#pragma unroll
        for (int dt = 0; dt < 4; ++dt) {
            const u32x2 gv = *(const u32x2*)(gp + 16 * dt); const f32x4 gw = *(const f32x4*)(gn + 64 * hf + 16 * dt + 4 * fq); const f32x4 v = acc[dt][ti];
            const float o0 = v[0] * rinv * gw[0] * silu_f(bf2f(gv.x & 0xffffu)), o1 = v[1] * rinv * gw[1] * silu_f(bf2f(gv.x >> 16));
            const float o2 = v[2] * rinv * gw[2] * silu_f(bf2f(gv.y & 0xffffu)), o3 = v[3] * rinv * gw[3] * silu_f(bf2f(gv.y >> 16));
            u32x2 w; w.x = pk2(o0, o1); w.y = pk2(o2, o3);
            *(u32x2*)(op + 16 * dt) = w;
        }
    }
}
__device__ __forceinline__ void s5_scan(const Frame& F) {
    const float* lam_re = F.a->in[I_LAMRE]; const float* lam_im = F.a->in[I_LAMIM]; const float* log_dt = F.a->in[I_LOGDT];
    for (int idx = F.bid * 512 + FTID; idx < NB * 2 * 32 * 64; idx += F.G * 512) {
        const int p = idx & 63, g = (idx >> 6) & 31, d = (idx >> 11) & 1, b = idx >> 12;
        const int gp = (d * 32 + g) * 64 + p;
        const float dt = __expf(log_dt[d * 32 + g]);
        const float mag = expf(lam_re[gp] * dt * (float)S5TC); float sn, cs; sincosf(lam_im[gp] * dt * (float)S5TC, &sn, &cs);
        const float ar = mag * cs, ai = mag * sn;
        const float* Z = WSP(float, B_ZS5) + (size_t)g * S5ROWS * 256 + d * 128 + p;
        bf16_t* H = WSP(bf16_t, B_AS5) + (size_t)g * S5ROWS * S5K + S5KU + d * 128 + p;
        float hr = 0.f, hi = 0.f;
        constexpr int NSTEP = (CTX + SEQ) / S5TC;
        for (int s = 0; s < NSTEP; s += 33) {
            float zr[33], zi[33]; int rows[33];
#pragma unroll
            for (int q = 0; q < 33; ++q) {
                const int st = s + q; int row;
                if (st < CTX / S5TC) { const int c = d == 0 ? st : CTX / S5TC - 1 - st; row = 1024 + b * (CTX / S5TC) + c; }
                else { const int c = d == 0 ? st - CTX / S5TC : SEQ / S5TC - 1 - (st - CTX / S5TC); row = b * (SEQ / S5TC) + c; }
                rows[q] = row; zr[q] = Z[(size_t)row * 256]; zi[q] = Z[(size_t)row * 256 + 64];
            }
#pragma unroll
            for (int q = 0; q < 33; ++q) {
                H[(size_t)rows[q] * S5K] = (bf16_t)f2bf(hr); H[(size_t)rows[q] * S5K + 64] = (bf16_t)f2bf(hi);
                const float nr = ar * hr - ai * hi + zr[q], ni = ar * hi + ai * hr + zi[q];
                hr = nr; hi = ni;
            }
        }
    }
}

struct RouteRec { int eid[2]; float gate[2]; int lrank[2]; int pos[2]; };
constexpr int RT_PITCH = 1032;
__device__ __forceinline__ void split_bf16(float x, unsigned& hi, unsigned& lo) { hi = f2bf(x); lo = f2bf(x - bf2f(hi)); }
__device__ __forceinline__ void router_phase(const Frame& F, int layer) {
    LAS bf16_t* thi = (LAS bf16_t*)F.lds;
    LAS bf16_t* tlo = thi + 16 * RT_PITCH;
    LAS float* part = (LAS float*)(F.lds + 66048);
    LAS float* lgt = (LAS float*)(F.lds + 66048 + 24576);
    LAS int* hist = (LAS int*)(F.lds + 66048 + 24576 + 3072);
    const int lane = FLANE, w = F.wave, fr = lane & 15, fq = lane >> 4;
    const float* wg = F.a->in[I_WG] + (size_t)layer * 1024 * 4; const float* we = F.a->in[I_WE] + (size_t)layer * 1024 * 32;
    const float* bg = F.a->in[I_BG] + layer * 4; const float* be = F.a->in[I_BE] + layer * 32;
    const float* mod = WSP(float, M_MOD) + (size_t)layer * 5 * 6144;
    bf16x8 bhi[4][3], blo[4][3];
#pragma unroll
    for (int kc = 0; kc < 4; ++kc)
#pragma unroll
        for (int nt = 0; nt < 3; ++nt) {
            const int n = 16 * nt + fr; unsigned h2[4], l2[4];
#pragma unroll
            for (int e = 0; e < 4; ++e) {
                unsigned hh[2], ll[2];
#pragma unroll
                for (int q = 0; q < 2; ++q) { const int k = 128 * w + 32 * kc + 8 * fq + 2 * e + q;
                    const float v = n < 4 ? wg[k * 4 + n] : (n < 36 ? we[k * 32 + (n - 4)] : 0.f); split_bf16(v, hh[q], ll[q]); }
                h2[e] = hh[0] | (hh[1] << 16); l2[e] = ll[0] | (ll[1] << 16);
            }
            bhi[kc][nt] = __builtin_bit_cast(bf16x8, (u32x4){h2[0], h2[1], h2[2], h2[3]}); blo[kc][nt] = __builtin_bit_cast(bf16x8, (u32x4){l2[0], l2[1], l2[2], l2[3]});
        }
    if (FTID < 32) hist[FTID] = 0;
    const int T0 = layer == 0 ? 0 : NCTX, ngroups = (NTOK - T0) / 16;
    RouteRec* rr = WSP(RouteRec, M_ROUTE);
    u32x2 vpre[2][4];
    if (F.bid < ngroups) {
#pragma unroll
        for (int r2 = 0; r2 < 2; ++r2) { const u32x2* xr = (const u32x2*)(WSP(bf16_t, B_X1) + (size_t)(T0 + F.bid * 16 + 2 * w + r2) * 1024) + lane;
#pragma unroll
            for (int j = 0; j < 4; ++j) vpre[r2][j] = xr[64 * j]; }
    }
    for (int gi = F.bid; gi < ngroups; gi += F.G) {
        __syncthreads();
#pragma unroll
        for (int r2 = 0; r2 < 2; ++r2) {
            const int row = 2 * w + r2, T = T0 + gi * 16 + row;
            const float* m = mod + tok_b5(T) * 6144;
            f32x4 v[4]; float s = 0.f;
#pragma unroll
            for (int j = 0; j < 4; ++j) { const u32x2 p = vpre[r2][j]; v[j] = (f32x4){bf2f(p.x & 0xffffu), bf2f(p.x >> 16), bf2f(p.y & 0xffffu), bf2f(p.y >> 16)}; s += (v[j].x * v[j].x + v[j].y * v[j].y) + (v[j].z * v[j].z + v[j].w * v[j].w); }
            const float rinv = rsqrtf(wave_sum(s) * (1.f / 1024.f) + EPS);
            unsigned long long* o8 = (unsigned long long*)(WSP(bf16_t, B_ABUF) + (size_t)T * 1024) + lane;
#pragma unroll
            for (int j = 0; j < 4; ++j) {
                const f32x4 sh = ((const f32x4*)(m + 3 * 1024))[lane + 64 * j], sl = ((const f32x4*)(m + 4 * 1024))[lane + 64 * j];
                const f32x4 hv = v[j] * rinv * (sl + 1.f) + sh;
                unsigned h0, h1, h2, h3, l0, l1, l2, l3;
                split_bf16(hv.x, h0, l0); split_bf16(hv.y, h1, l1); split_bf16(hv.z, h2, l2); split_bf16(hv.w, h3, l3);
                o8[64 * j] = (unsigned long long)(h0 | (h1 << 16)) | ((unsigned long long)(h2 | (h3 << 16)) << 32);
                *(LAS u32x2*)(thi + row * RT_PITCH + 4 * lane + 256 * j) = (u32x2){h0 | (h1 << 16), h2 | (h3 << 16)};
                *(LAS u32x2*)(tlo + row * RT_PITCH + 4 * lane + 256 * j) = (u32x2){l0 | (l1 << 16), l2 | (l3 << 16)};
            }
            if (gi + F.G < ngroups) { const u32x2* xn = (const u32x2*)(WSP(bf16_t, B_X1) + (size_t)(T + F.G * 16) * 1024) + lane;
#pragma unroll
                for (int j = 0; j < 4; ++j) vpre[r2][j] = xn[64 * j]; }
        }
        __syncthreads();
        f32x4 acc[3] = {(f32x4){0.f, 0.f, 0.f, 0.f}, (f32x4){0.f, 0.f, 0.f, 0.f}, (f32x4){0.f, 0.f, 0.f, 0.f}};
#pragma unroll
        for (int kc = 0; kc < 4; ++kc) {
            const bf16x8 ah = *(const LAS bf16x8*)(thi + fr * RT_PITCH + 128 * w + 32 * kc + 8 * fq), al = *(const LAS bf16x8*)(tlo + fr * RT_PITCH + 128 * w + 32 * kc + 8 * fq);
#pragma unroll
            for (int nt = 0; nt < 3; ++nt) {
                acc[nt] = __builtin_amdgcn_mfma_f32_16x16x32_bf16(ah, bhi[kc][nt], acc[nt], 0, 0, 0);
                acc[nt] = __builtin_amdgcn_mfma_f32_16x16x32_bf16(ah, blo[kc][nt], acc[nt], 0, 0, 0);
                acc[nt] = __builtin_amdgcn_mfma_f32_16x16x32_bf16(al, bhi[kc][nt], acc[nt], 0, 0, 0);
            }
        }
#pragma unroll
        for (int nt = 0; nt < 3; ++nt)
#pragma unroll
            for (int i = 0; i < 4; ++i) part[(w * 16 + 4 * fq + i) * 48 + 16 * nt + fr] = acc[nt][i];
        __syncthreads();
        for (int i = FTID; i < 16 * 48; i += 512) { float s = 0.f;
#pragma unroll
            for (int ww = 0; ww < 8; ++ww) s += part[ww * 768 + i];
            lgt[i] = s; }
        __syncthreads();
        if (FTID < 16) {
            const int T = T0 + gi * 16 + FTID; const LAS float* l = lgt + FTID * 48;
            float lg[4]; int grp = 0; float mx = -3.0e38f;
#pragma unroll
            for (int q = 0; q < 4; ++q) { lg[q] = l[q] + bg[q]; if (lg[q] > mx) { mx = lg[q]; grp = q; } }
            float zs = 0.f;
#pragma unroll
            for (int q = 0; q < 4; ++q) zs += __expf(lg[q] - mx);
            const float gw = 1.f / zs;
            float le[8]; int i1 = 0; float m1 = -3.0e38f;
#pragma unroll
            for (int q = 0; q < 8; ++q) { const float v = l[4 + grp * 8 + q] + be[grp * 8 + q];
                le[q] = v; if (v > m1) { m1 = v; i1 = q; } }
            int i2 = 0; float m2 = -3.0e38f;
#pragma unroll
            for (int q = 0; q < 8; ++q) { if (q != i1 && le[q] > m2) { m2 = le[q]; i2 = q; } }
            const float e2 = __expf(m2 - m1), den = 1.f + e2;
            RouteRec rec;
            rec.eid[0] = grp * 8 + i1; rec.eid[1] = grp * 8 + i2; rec.gate[0] = gw / den; rec.gate[1] = gw * e2 / den;
            rec.lrank[0] = atomicAdd((int*)&hist[rec.eid[0]], 1); rec.lrank[1] = atomicAdd((int*)&hist[rec.eid[1]], 1);
            rec.pos[0] = 0; rec.pos[1] = 0;
            rr[T] = rec;
        }
    }
    __syncthreads();
    if (FTID < 32) WSP(int, M_HIST)[F.bid * 32 + FTID] = hist[FTID];
}

__device__ __forceinline__ void placement_phase(const Frame& F, int layer) {
    LAS int* base = (LAS int*)F.lds;
    LAS int* tot = base + 256 * 32;
    LAS int* pstart = tot + 32;
    const int* hist = WSP(int, M_HIST);
    __syncthreads();
    if (FTID < 32) { int run = 0; for (int bk = 0; bk < F.G; ++bk) { base[bk * 32 + FTID] = run; run += hist[bk * 32 + FTID]; } tot[FTID] = run; }
    __syncthreads();
    if (FTID == 0) { int run = 0; for (int e = 0; e < 32; ++e) { pstart[e] = run; run += (tot[e] + 255) / 256 * 256; } pstart[32] = run; }
    __syncthreads();
    int* tokbuf = WSP(int, M_TOKBUF); float* gatebuf = WSP(float, M_GATEBUF); int* tiles = WSP(int, M_TILES);
    if (F.bid == 0) {
        if (FTID == 0) tiles[0] = pstart[32] / 256;
        if (FTID < 32) { const int t0 = pstart[FTID] / 256, t1 = pstart[FTID + 1] / 256; for (int t = t0; t < t1; ++t) tiles[1 + t] = FTID; }
    }
    for (int e = F.bid; e < 32; e += F.G) { const int p0 = pstart[e] + tot[e], p1 = pstart[e + 1]; for (int p = p0 + FTID; p < p1; p += 512) { tokbuf[p] = 0; gatebuf[p] = 0.f; } }
    const int T0 = layer == 0 ? 0 : NCTX, ngroups = (NTOK - T0) / 16;
    RouteRec* rr = WSP(RouteRec, M_ROUTE);
    for (int i = F.bid * 512 + FTID; i < (NTOK - T0) * 2; i += F.G * 512) {
        const int T = T0 + (i >> 1), k = i & 1, gi = (T - T0) >> 4, owner = gi % F.G;
        const int e = rr[T].eid[k], pos = pstart[e] + base[owner * 32 + e] + rr[T].lrank[k];
        rr[T].pos[k] = pos; tokbuf[pos] = T; gatebuf[pos] = rr[T].gate[k];
    }
    (void)ngroups;
}

__device__ __forceinline__ void combine_norm1_phase(const Frame& F) {
    const int gw = F.bid * 8 + F.wave, NGW = F.G * 8, lane = FLANE;
    const float* mod0 = WSP(float, M_MOD); const float* mod1 = mod0 + 5 * 6144;
    const RouteRec* rr = WSP(RouteRec, M_ROUTE); const bf16_t* YB = WSP(bf16_t, B_YB);
    int pn[2][2] = {{0, 0}, {0, 0}}; float gn[2][2] = {{0.f, 0.f}, {0.f, 0.f}};
#pragma unroll
    for (int e = 0; e < 2; ++e) { const int T = gw + e * NGW; if (T < NTOK) { pn[e][0] = rr[T].pos[0]; pn[e][1] = rr[T].pos[1]; gn[e][0] = rr[T].gate[0]; gn[e][1] = rr[T].gate[1]; } }
    for (int T0 = gw; T0 < NTOK; T0 += 2 * NGW) {
        u32x2 xv[2][4]; unsigned long long ya[2][4], yb[2][4]; float g0[2], g1[2]; bool ok[2]; u32x2* xr[2];
#pragma unroll
        for (int e = 0; e < 2; ++e) {
            const int T = T0 + e * NGW; ok[e] = T < NTOK; const int Tc = ok[e] ? T : T0;
            xr[e] = (u32x2*)(WSP(bf16_t, B_X1) + (size_t)Tc * 1024) + lane;
            const unsigned long long* y0 = (const unsigned long long*)(YB + (size_t)pn[e][0] * 1024) + lane;
            const unsigned long long* y1 = (const unsigned long long*)(YB + (size_t)pn[e][1] * 1024) + lane;
            g0[e] = gn[e][0]; g1[e] = gn[e][1];
#pragma unroll
            for (int j = 0; j < 4; ++j) { xv[e][j] = xr[e][64 * j]; ya[e][j] = y0[64 * j]; yb[e][j] = y1[64 * j]; }
        }
#pragma unroll
        for (int e = 0; e < 2; ++e) { const int Tn = T0 + (2 + e) * NGW; if (Tn < NTOK) { pn[e][0] = rr[Tn].pos[0]; pn[e][1] = rr[Tn].pos[1]; gn[e][0] = rr[Tn].gate[0]; gn[e][1] = rr[Tn].gate[1]; } }
#pragma unroll
        for (int e = 0; e < 2; ++e) {
            const int T = T0 + e * NGW;
            if (ok[e]) {
                const int b5 = tok_b5(T);
                const f32x4* g2 = (const f32x4*)(mod0 + b5 * 6144 + 5 * 1024) + lane;
                f32x4 v[4]; float s = 0.f;
#pragma unroll
                for (int j = 0; j < 4; ++j) {
                    const unsigned long long a = ya[e][j], c = yb[e][j]; const float gt0 = g0[e], gt1 = g1[e];
                    f32x4 y; y.x = gt0 * bf2f((unsigned)a & 0xffffu) + gt1 * bf2f((unsigned)c & 0xffffu); y.y = gt0 * bf2f(((unsigned)a) >> 16) + gt1 * bf2f(((unsigned)c) >> 16);
                    y.z = gt0 * bf2f((unsigned)(a >> 32) & 0xffffu) + gt1 * bf2f((unsigned)(c >> 32) & 0xffffu); y.w = gt0 * bf2f((unsigned)(a >> 48)) + gt1 * bf2f((unsigned)(c >> 48));
                    const u32x2 xp = xv[e][j];
                    v[j] = (f32x4){bf2f(xp.x & 0xffffu), bf2f(xp.x >> 16), bf2f(xp.y & 0xffffu), bf2f(xp.y >> 16)} + g2[64 * j] * y;
                    xr[e][64 * j] = (u32x2){pk2(v[j].x, v[j].y), pk2(v[j].z, v[j].w)};
                    s += (v[j].x * v[j].x + v[j].y * v[j].y) + (v[j].z * v[j].z + v[j].w * v[j].w);
                }
                const float rinv = rsqrtf(wave_sum(s) * (1.f / 1024.f) + EPS);
                const float* m = mod1 + b5 * 6144;
                unsigned long long* o8 = (unsigned long long*)(WSP(bf16_t, B_ABUF) + (size_t)T * 1024) + lane;
#pragma unroll
                for (int j = 0; j < 4; ++j) {
                    const f32x4 sh = ((const f32x4*)m)[lane + 64 * j], sl = ((const f32x4*)(m + 1024))[lane + 64 * j];
                    const f32x4 h = v[j] * rinv * (sl + 1.f) + sh;
                    o8[64 * j] = (unsigned long long)pk2(h.x, h.y) | ((unsigned long long)pk2(h.z, h.w) << 32);
                }
            }
        }
    }
}
__device__ __forceinline__ void final_phase(const Frame& F) {
    const int gw = F.bid * 8 + F.wave, NGW = F.G * 8, lane = FLANE;
    const float* mod1 = WSP(float, M_MOD) + 5 * 6144;
    const RouteRec* rr = WSP(RouteRec, M_ROUTE); const bf16_t* YB = WSP(bf16_t, B_YB);
    int pn[2][2] = {{0, 0}, {0, 0}}; float gn[2][2] = {{0.f, 0.f}, {0.f, 0.f}};
#pragma unroll
    for (int e = 0; e < 2; ++e) { const int Tl = gw + e * NGW; if (Tl < NLAT) { const RouteRec* q = rr + NCTX + Tl; pn[e][0] = q->pos[0]; pn[e][1] = q->pos[1]; gn[e][0] = q->gate[0]; gn[e][1] = q->gate[1]; } }
    for (int Tl0 = gw; Tl0 < NLAT; Tl0 += 2 * NGW) {
        u32x2 xv[2][4]; unsigned long long ya[2][4], yb[2][4]; float g0[2], g1[2]; bool ok[2];
#pragma unroll
        for (int e = 0; e < 2; ++e) {
            const int Tl = Tl0 + e * NGW; ok[e] = Tl < NLAT; const int Tc = ok[e] ? Tl : Tl0;
            const u32x2* xr = (const u32x2*)(WSP(bf16_t, B_X1) + (size_t)(NCTX + Tc) * 1024) + lane;
            const unsigned long long* y0 = (const unsigned long long*)(YB + (size_t)pn[e][0] * 1024) + lane;
            const unsigned long long* y1 = (const unsigned long long*)(YB + (size_t)pn[e][1] * 1024) + lane;
            g0[e] = gn[e][0]; g1[e] = gn[e][1];
#pragma unroll
            for (int j = 0; j < 4; ++j) { xv[e][j] = xr[64 * j]; ya[e][j] = y0[64 * j]; yb[e][j] = y1[64 * j]; }
        }
#pragma unroll
        for (int e = 0; e < 2; ++e) { const int Tn = Tl0 + (2 + e) * NGW; if (Tn < NLAT) { const RouteRec* q = rr + NCTX + Tn; pn[e][0] = q->pos[0]; pn[e][1] = q->pos[1]; gn[e][0] = q->gate[0]; gn[e][1] = q->gate[1]; } }
#pragma unroll
        for (int e = 0; e < 2; ++e) {
            const int Tl = Tl0 + e * NGW;
            if (ok[e]) {
                const f32x4* g2 = (const f32x4*)(mod1 + (Tl / SEQ) * 6144 + 5 * 1024) + lane;
                f32x4* o = (f32x4*)(F.a->out + (size_t)Tl * 1024) + lane;
#pragma unroll
                for (int j = 0; j < 4; ++j) {
                    const unsigned long long a = ya[e][j], c = yb[e][j]; const float gt0 = g0[e], gt1 = g1[e];
                    f32x4 y; y.x = gt0 * bf2f((unsigned)a & 0xffffu) + gt1 * bf2f((unsigned)c & 0xffffu); y.y = gt0 * bf2f(((unsigned)a) >> 16) + gt1 * bf2f(((unsigned)c) >> 16);
                    y.z = gt0 * bf2f((unsigned)(a >> 32) & 0xffffu) + gt1 * bf2f((unsigned)(c >> 32) & 0xffffu); y.w = gt0 * bf2f((unsigned)(a >> 48)) + gt1 * bf2f((unsigned)(c >> 48));
                    const u32x2 xp = xv[e][j];
                    o[64 * j] = (f32x4){bf2f(xp.x & 0xffffu), bf2f(xp.x >> 16), bf2f(xp.y & 0xffffu), bf2f(xp.y >> 16)} + g2[64 * j] * y;
                }
            }
        }
    }
}
#ifndef FFT_HD
#define FFT_HD __device__ __forceinline__
#endif
typedef float cpx __attribute__((ext_vector_type(2)));
#ifndef FFT_OPAQUE
#define FFT_OPAQUE(x) asm volatile("" : "+v"(x))
#endif
#define W16C(k) ((k) == 0 ? 1.0f : (k) == 1 ? 0.9238795325112867f : (k) == 2 ? 0.7071067811865476f : (k) == 3 ? 0.3826834323650898f : (k) == 4 ? 0.0f : (k) == 5 ? -0.3826834323650898f : (k) == 6 ? -0.7071067811865476f : (k) == 7 ? -0.9238795325112867f : (k) == 8 ? -1.0f : -0.9238795325112867f)
#define W16S(k) ((k) == 0 ? 0.0f : (k) == 1 ? -0.3826834323650898f : (k) == 2 ? -0.7071067811865476f : (k) == 3 ? -0.9238795325112867f : (k) == 4 ? -1.0f : (k) == 5 ? -0.9238795325112867f : (k) == 6 ? -0.7071067811865476f : (k) == 7 ? -0.3826834323650898f : (k) == 8 ? 0.0f : 0.3826834323650898f)
FFT_HD cpx cmul(cpx a, cpx b) { return (cpx){a.x * b.x - a.y * b.y, a.x * b.y + a.y * b.x}; }
FFT_HD cpx cmulc(cpx a, cpx b) { return (cpx){a.x * b.x + a.y * b.y, a.y * b.x - a.x * b.y}; }
FFT_HD int fft_ph(int p) { return p + (p >> 4); }
constexpr int FFT_LDS_ELEMS = 16384 + 1024;
template <bool INV> FFT_HD void dft4(cpx& a, cpx& b, cpx& c, cpx& d) {
    const cpx s0 = a + c, s1 = a - c, s2 = b + d, s3 = b - d;
    a = s0 + s2; c = s0 - s2;
    if (!INV) { b = (cpx){s1.x + s3.y, s1.y - s3.x}; d = (cpx){s1.x - s3.y, s1.y + s3.x}; }
    else      { b = (cpx){s1.x - s3.y, s1.y + s3.x}; d = (cpx){s1.x + s3.y, s1.y - s3.x}; }
}
template <class Buf, class Tw>
FFT_HD void fft_fwd_pass_r4(Buf buf, Tw tw, int tid, int nthreads) {
    FFT_OPAQUE(tid);
#pragma unroll 1
    for (int j = tid; j < 4096; j += nthreads) {
        const int pj = fft_ph(j);
        cpx v0 = buf[pj], v1 = buf[pj + 4352], v2 = buf[pj + 8704], v3 = buf[pj + 13056];
        dft4<false>(v0, v1, v2, v3);
        const cpx w1 = tw[j], w2 = cmul(w1, w1), w3 = cmul(w2, w1);
        buf[pj] = v0; buf[pj + 4352] = cmul(v1, w1); buf[pj + 8704] = cmul(v2, w2); buf[pj + 13056] = cmul(v3, w3);
    }
}
template <class Buf, class Tw>
FFT_HD void fft_inv_pass_r4(Buf buf, Tw tw, int tid, int nthreads) {
    FFT_OPAQUE(tid);
#pragma unroll 1
    for (int j = tid; j < 4096; j += nthreads) {
        const cpx w1 = tw[j], w2 = cmul(w1, w1), w3 = cmul(w2, w1);
        const int pj = fft_ph(j);
        cpx v0 = buf[pj], v1 = cmulc(buf[pj + 4352], w1), v2 = cmulc(buf[pj + 8704], w2), v3 = cmulc(buf[pj + 13056], w3);
        dft4<true>(v0, v1, v2, v3);
        buf[pj] = v0; buf[pj + 4352] = v1; buf[pj + 8704] = v2; buf[pj + 13056] = v3;
    }
}
template <int N_, class Buf, class Tw>
FFT_HD void fft_fwd_pass_r16(Buf buf, Tw tw, int tid, int nthreads) {
    FFT_OPAQUE(tid);
    constexpr int S = N_ / 16, TWS1 = 16384 / N_, TWS2 = 16384 / (N_ / 4);
#pragma unroll 1
    for (int it = tid; it < 1024; it += nthreads) {
        const int j0 = it % S, blk = it / S, base = blk * N_ + j0, pb = fft_ph(base);
        constexpr int PS = S + S / 16;
        cpx v[16];
#pragma unroll
        for (int q = 0; q < 16; ++q) v[q] = buf[pb + q * PS];
#pragma unroll
        for (int i = 0; i < 4; ++i) {
            dft4<false>(v[i], v[4 + i], v[8 + i], v[12 + i]);
            if (N_ > 16) { const cpx w1 = tw[((j0 + i * S) * TWS1) & 16383], w2 = cmul(w1, w1), w3 = cmul(w2, w1);
                v[4 + i] = cmul(v[4 + i], w1); v[8 + i] = cmul(v[8 + i], w2); v[12 + i] = cmul(v[12 + i], w3); }
            else { const cpx w1 = (cpx){W16C(i), W16S(i)}, w2 = (cpx){W16C(2 * i), W16S(2 * i)}, w3 = (cpx){W16C(3 * i), W16S(3 * i)};
                v[4 + i] = cmul(v[4 + i], w1); v[8 + i] = cmul(v[8 + i], w2); v[12 + i] = cmul(v[12 + i], w3); }
        }
#pragma unroll
        for (int m = 0; m < 4; ++m) {
            dft4<false>(v[4 * m], v[4 * m + 1], v[4 * m + 2], v[4 * m + 3]);
            if (N_ > 16) { const cpx w1 = tw[(j0 * TWS2) & 16383], w2 = cmul(w1, w1), w3 = cmul(w2, w1);
                v[4 * m + 1] = cmul(v[4 * m + 1], w1); v[4 * m + 2] = cmul(v[4 * m + 2], w2); v[4 * m + 3] = cmul(v[4 * m + 3], w3); }
        }
#pragma unroll
        for (int q = 0; q < 16; ++q) buf[pb + q * PS] = v[q];
    }
}
template <int N_, class Buf, class Tw>
FFT_HD void fft_inv_pass_r16(Buf buf, Tw tw, int tid, int nthreads) {
    FFT_OPAQUE(tid);
    constexpr int S = N_ / 16, TWS1 = 16384 / N_, TWS2 = 16384 / (N_ / 4);
#pragma unroll 1
    for (int it = tid; it < 1024; it += nthreads) {
        const int j0 = it % S, blk = it / S, base = blk * N_ + j0, pb = fft_ph(base);
        constexpr int PS = S + S / 16;
        cpx v[16];
#pragma unroll
        for (int q = 0; q < 16; ++q) v[q] = buf[pb + q * PS];
#pragma unroll
        for (int m = 0; m < 4; ++m) {
            if (N_ > 16) { const cpx w1 = tw[(j0 * TWS2) & 16383], w2 = cmul(w1, w1), w3 = cmul(w2, w1);
                v[4 * m + 1] = cmulc(v[4 * m + 1], w1); v[4 * m + 2] = cmulc(v[4 * m + 2], w2); v[4 * m + 3] = cmulc(v[4 * m + 3], w3); }
            dft4<true>(v[4 * m], v[4 * m + 1], v[4 * m + 2], v[4 * m + 3]);
        }
#pragma unroll
        for (int i = 0; i < 4; ++i) {
            if (N_ > 16) { const cpx w1 = tw[((j0 + i * S) * TWS1) & 16383], w2 = cmul(w1, w1), w3 = cmul(w2, w1);
                v[4 + i] = cmulc(v[4 + i], w1); v[8 + i] = cmulc(v[8 + i], w2); v[12 + i] = cmulc(v[12 + i], w3); }
            else { const cpx w1 = (cpx){W16C(i), W16S(i)}, w2 = (cpx){W16C(2 * i), W16S(2 * i)}, w3 = (cpx){W16C(3 * i), W16S(3 * i)};
                v[4 + i] = cmulc(v[4 + i], w1); v[8 + i] = cmulc(v[8 + i], w2); v[12 + i] = cmulc(v[12 + i], w3); }
            dft4<true>(v[i], v[4 + i], v[8 + i], v[12 + i]);
        }
#pragma unroll
        for (int q = 0; q < 16; ++q) buf[pb + q * PS] = v[q];
    }
}
__device__ __forceinline__ void hf_unit(const Frame& F, int u) {
    LAS float* h3 = (LAS float*)F.lds;
    const int tb = u >> 1, t0 = tb * 64, col0 = (u & 1) * 512 + 64 * F.wave, lane = FLANE, fr = lane & 15, fq = lane >> 4;
    __syncthreads();
    for (int i = FTID; i < 64 * 64; i += 512) h3[(i >> 6) * 66 + (i & 63)] = WSP(float, M_H3)[(size_t)t0 * 64 + i];
    __syncthreads();
    f32x4 acc[4][4];
#pragma unroll
    for (int mt = 0; mt < 4; ++mt)
#pragma unroll
        for (int nt = 0; nt < 4; ++nt) acc[mt][nt] = (f32x4){0.f, 0.f, 0.f, 0.f};
    const float* fw4 = F.a->in[I_FW4] + col0 + fr;
    float bw[16][4];
#pragma unroll
    for (int ks = 0; ks < 16; ++ks)
#pragma unroll
        for (int nt = 0; nt < 4; ++nt) bw[ks][nt] = fw4[(size_t)(4 * ks + fq) * 1024 + 16 * nt];
#pragma unroll
    for (int ks = 0; ks < 16; ++ks) {
        float a[4];
#pragma unroll
        for (int mt = 0; mt < 4; ++mt) a[mt] = h3[(16 * mt + fr) * 66 + 4 * ks + fq];
#pragma unroll
        for (int mt = 0; mt < 4; ++mt)
#pragma unroll
            for (int nt = 0; nt < 4; ++nt) acc[mt][nt] = __builtin_amdgcn_mfma_f32_16x16x4f32(a[mt], bw[ks][nt], acc[mt][nt], 0, 0, 0);
    }
#pragma unroll
    for (int nt = 0; nt < 4; ++nt) {
        const int col = col0 + 16 * nt + fr, ch = col & 511;
        const float delta = 4.605170185988091f * (1.f / 1.5f + (float)ch * ((1.f / 0.3f - 1.f / 1.5f) / 511.f));
        float* o = WSP(float, B_HF) + (size_t)col * 8192 + t0 + 4 * fq;
#pragma unroll
        for (int mt = 0; mt < 4; ++mt) { f32x4 r;
#pragma unroll
            for (int i = 0; i < 4; ++i) r[i] = acc[mt][nt][i] * __expf(-(float)(t0 + 16 * mt + 4 * fq + i) * (1.f / 8191.f) * delta);
            *(f32x4*)(o + 16 * mt) = r; }
    }
}
struct TwLds { const LAS cpx* wa; const LAS cpx* wb; __device__ __forceinline__ cpx operator[](int k) const { return cmul(wa[k >> 7], wb[k & 127]); } };
constexpr int TW_LDS_OFF = FFT_LDS_ELEMS * 8;
__device__ __forceinline__ TwLds tw_lds_fill(const Frame& F) {
    LAS cpx* wa = (LAS cpx*)(F.lds + TW_LDS_OFF); LAS cpx* wb = wa + 128; const cpx* tw = WSP(cpx, M_TW);
    if (FTID < 128) wa[FTID] = tw[FTID * 128]; else if (FTID < 256) wb[FTID - 128] = tw[FTID - 128];
    return TwLds{wa, wb};
}
__device__ __forceinline__ void fft_fwd_all(LAS cpx* buf, const TwLds tw, int tid) {
    __syncthreads(); fft_fwd_pass_r4(buf, tw, tid, 512);
    __syncthreads(); fft_fwd_pass_r16<4096>(buf, tw, tid, 512);
    __syncthreads(); fft_fwd_pass_r16<256>(buf, tw, tid, 512);
    __syncthreads(); fft_fwd_pass_r16<16>(buf, tw, tid, 512);
    __syncthreads();
}
__device__ __forceinline__ void fft_inv_all(LAS cpx* buf, const TwLds tw, int tid) {
    __syncthreads(); fft_inv_pass_r16<16>(buf, tw, tid, 512);
    __syncthreads(); fft_inv_pass_r16<256>(buf, tw, tid, 512);
    __syncthreads(); fft_inv_pass_r16<4096>(buf, tw, tid, 512);
    __syncthreads(); fft_inv_pass_r4(buf, tw, tid, 512);
    __syncthreads();
}
__device__ __forceinline__ void kf_unit(const Frame& F, int ch) {
    LAS cpx* buf = (LAS cpx*)F.lds;
    __syncthreads();
    const TwLds tw = tw_lds_fill(F);
    const float* hf = WSP(float, B_HF) + (size_t)ch * 8192; const float* hb = WSP(float, B_HF) + (size_t)(512 + ch) * 8192;
    {
        const int p0 = 16 * FTID;
        f32x4 a[4];
#pragma unroll
        for (int q = 0; q < 4; ++q) a[q] = *(const f32x4*)(hf + p0 + 4 * q);
        float r[16];
#pragma unroll
        for (int i = 0; i < 16; ++i) { const int p = 8192 + p0 + i; r[i] = p > 8192 ? hb[FFTN - p] : 0.f; }
#pragma unroll
        for (int q = 0; q < 4; ++q)
#pragma unroll
            for (int i = 0; i < 4; ++i) buf[fft_ph(p0 + 4 * q + i)] = (cpx){a[q][i], 0.f};
#pragma unroll
        for (int i = 0; i < 16; ++i) buf[fft_ph(8192 + p0 + i)] = (cpx){r[i], 0.f};
    }
    fft_fwd_all(buf, tw, FTID);
    f32x4* kf = (f32x4*)(WSP(cpx, B_KF) + (size_t)ch * FFTN);
#pragma unroll
    for (int j = 0; j < 8; ++j) {
        const int p0 = 4 * (FTID + 512 * j);
        const cpx v0 = buf[fft_ph(p0)], v1 = buf[fft_ph(p0 + 1)], v2 = buf[fft_ph(p0 + 2)], v3 = buf[fft_ph(p0 + 3)];
        const float sc = 1.f / 16384.f;
        kf[p0 / 2] = (f32x4){v0.x * sc, v0.y * sc, v1.x * sc, v1.y * sc}; kf[p0 / 2 + 1] = (f32x4){v2.x * sc, v2.y * sc, v3.x * sc, v3.y * sc};
    }
}
__device__ __forceinline__ void hy_conv16(const bf16_t* z, int t0, float w0, float w1, float w2, float bias, float (&o)[16]) {
    const u32x4 a = *(const u32x4*)(z + t0), b = *(const u32x4*)(z + t0 + 8);
    float v[18];
    v[0] = t0 > 0 ? bf2f(z[t0 - 1]) : 0.f; v[17] = t0 + 16 < 8192 ? bf2f(z[t0 + 16]) : 0.f;
    const unsigned rw[8] = {a.x, a.y, a.z, a.w, b.x, b.y, b.z, b.w};
#pragma unroll
    for (int e = 0; e < 8; ++e) { v[1 + 2 * e] = bf2f(rw[e] & 0xffffu); v[2 + 2 * e] = bf2f(rw[e] >> 16); }
#pragma unroll
    for (int i = 0; i < 16; ++i) o[i] = bias + w0 * v[i] + w1 * v[i + 1] + w2 * v[i + 2];
}
__device__ __forceinline__ void hyconv_unit(const Frame& F, int u, int var) {
    LAS cpx* buf = (LAS cpx*)F.lds;
    __syncthreads();
    const TwLds tw = tw_lds_fill(F);
    const int ch = u >> 1, bp = u & 1, t0 = 16 * FTID;
    const bf16_t* Z = WSP(bf16_t, B_ZHT);
    const float* cw = F.a->in[I_CONVW]; const float* cb = F.a->in[I_CONVB];
    float w[3][3], bb[3];
#pragma unroll
    for (int g = 0; g < 3; ++g) { bb[g] = cb[g * 512 + ch];
#pragma unroll
        for (int j = 0; j < 3; ++j) w[g][j] = cw[j * 1536 + g * 512 + ch]; }
    const float hbias = F.a->in[I_HBIAS][ch];
    if (var != 2) {
        float x1[16], vv[16], u0[16];
        hy_conv16(Z + (size_t)(512 + ch) * NLAT + (2 * bp) * 8192, t0, w[1][0], w[1][1], w[1][2], bb[1], x1);
        hy_conv16(Z + (size_t)(1024 + ch) * NLAT + (2 * bp) * 8192, t0, w[2][0], w[2][1], w[2][2], bb[2], vv);
#pragma unroll
        for (int i = 0; i < 16; ++i) u0[i] = x1[i] * vv[i];
        hy_conv16(Z + (size_t)(512 + ch) * NLAT + (2 * bp + 1) * 8192, t0, w[1][0], w[1][1], w[1][2], bb[1], x1);
        hy_conv16(Z + (size_t)(1024 + ch) * NLAT + (2 * bp + 1) * 8192, t0, w[2][0], w[2][1], w[2][2], bb[2], vv);
#pragma unroll
        for (int i = 0; i < 16; ++i) { buf[fft_ph(t0 + i)] = (cpx){u0[i], x1[i] * vv[i]}; buf[fft_ph(8192 + t0 + i)] = (cpx){0.f, 0.f}; }
    }
    if (var != 1) fft_fwd_all(buf, tw, FTID);
    {
        const f32x4* kf = (const f32x4*)(WSP(cpx, B_KF) + (size_t)ch * FFTN);
        f32x4 k0[8], k1[8];
#pragma unroll
        for (int j = 0; j < 8; ++j) { const int p0 = 4 * (FTID + 512 * j); k0[j] = kf[p0 / 2]; k1[j] = kf[p0 / 2 + 1]; }
#pragma unroll
        for (int j = 0; j < 8; ++j) { const int p0 = 4 * (FTID + 512 * j);
            buf[fft_ph(p0)] = cmul(buf[fft_ph(p0)], (cpx){k0[j][0], k0[j][1]}); buf[fft_ph(p0 + 1)] = cmul(buf[fft_ph(p0 + 1)], (cpx){k0[j][2], k0[j][3]});
            buf[fft_ph(p0 + 2)] = cmul(buf[fft_ph(p0 + 2)], (cpx){k1[j][0], k1[j][1]}); buf[fft_ph(p0 + 3)] = cmul(buf[fft_ph(p0 + 3)], (cpx){k1[j][2], k1[j][3]}); }
    }
    if (var != 1) fft_inv_all(buf, tw, FTID);
    bf16_t* o = WSP(bf16_t, B_HYT) + (size_t)ch * NLAT;
    if (var != 2)
#pragma unroll
    for (int q = 0; q < 2; ++q) {
        const int b = 2 * bp + q;
        float x0[16], x1[16], vv[16];
        hy_conv16(Z + (size_t)(ch) * NLAT + b * 8192, t0, w[0][0], w[0][1], w[0][2], bb[0], x0);
        hy_conv16(Z + (size_t)(512 + ch) * NLAT + b * 8192, t0, w[1][0], w[1][1], w[1][2], bb[1], x1);
        hy_conv16(Z + (size_t)(1024 + ch) * NLAT + b * 8192, t0, w[2][0], w[2][1], w[2][2], bb[2], vv);
        float r[16];
#pragma unroll
        for (int i = 0; i < 16; ++i) { const cpx y = buf[fft_ph(t0 + i)]; r[i] = x0[i] * ((q == 0 ? y.x : y.y) + x1[i] * vv[i] * hbias); }
        u32x4 s0, s1;
        s0.x = pk2(r[0], r[1]); s0.y = pk2(r[2], r[3]); s0.z = pk2(r[4], r[5]); s0.w = pk2(r[6], r[7]);
        s1.x = pk2(r[8], r[9]); s1.y = pk2(r[10], r[11]); s1.z = pk2(r[12], r[13]); s1.w = pk2(r[14], r[15]);
        *(u32x4*)(o + b * 8192 + t0) = s0; *(u32x4*)(o + b * 8192 + t0 + 8) = s1;
    }
}
__device__ __forceinline__ void hy_transpose_item(const Frame& F, int it, LAS bf16_t* scr  ) {
    const int cb = it & 7, tb = it >> 3, lane = FLANE, r8 = lane >> 3, c8 = lane & 7;
    const bf16_t* src = WSP(bf16_t, B_HYT) + (size_t)(cb * 64 + r8) * NLAT + tb * 64 + 8 * c8;
    u32x4 v[8];
#pragma unroll
    for (int j = 0; j < 8; ++j) v[j] = *(const u32x4*)(src + (size_t)(8 * j) * NLAT);
#pragma unroll
    for (int j = 0; j < 8; ++j) *(LAS u32x4*)(scr + (r8 + 8 * j) * 72 + 8 * c8) = v[j];
    LDS_WAIT(); asm volatile("" ::: "memory");
    bf16_t* dst = WSP(bf16_t, B_MIX1) + (size_t)(tb * 64 + r8) * 1024 + 512 + cb * 64 + 8 * c8;
#pragma unroll
    for (int j = 0; j < 8; ++j) {
        unsigned w[4];
#pragma unroll
        for (int e = 0; e < 4; ++e) w[e] = (unsigned)scr[(8 * c8 + 2 * e) * 72 + r8 + 8 * j] | ((unsigned)scr[(8 * c8 + 2 * e + 1) * 72 + r8 + 8 * j] << 16);
        *(u32x4*)(dst + (size_t)(8 * j) * 1024) = (u32x4){w[0], w[1], w[2], w[3]};
    }
    LDS_WAIT(); asm volatile("" ::: "memory");
}

__device__ __forceinline__ void qknorm_row(bf16_t* row, const float* nw, float extra, int lane) {
    u32x4* p = (u32x4*)row + lane;
    const u32x4 raw = *p; const unsigned rw[4] = {raw.x, raw.y, raw.z, raw.w};
    float v[8]; float ss = 0.f;
#pragma unroll
    for (int e = 0; e < 4; ++e) { v[2 * e] = bf2f(rw[e] & 0xffffu); v[2 * e + 1] = bf2f(rw[e] >> 16); ss += v[2 * e] * v[2 * e] + v[2 * e + 1] * v[2 * e + 1]; }
    ss += __shfl_xor(ss, 1); ss += __shfl_xor(ss, 2); ss += __shfl_xor(ss, 4);
    const float rinv = rsqrtf(ss * (1.f / 64.f) + EPS) * extra;
    const f32x4 n0 = *(const f32x4*)(nw + 8 * (lane & 7)), n1 = *(const f32x4*)(nw + 8 * (lane & 7) + 4);
    u32x4 o; o.x = pk2(v[0] * rinv * n0[0], v[1] * rinv * n0[1]); o.y = pk2(v[2] * rinv * n0[2], v[3] * rinv * n0[3]);
    o.z = pk2(v[4] * rinv * n1[0], v[5] * rinv * n1[1]); o.w = pk2(v[6] * rinv * n1[2], v[7] * rinv * n1[3]);
    *p = o;
}
__device__ __forceinline__ void qknorm_phase(const Frame& F) {
    const int gw = F.bid * 8 + F.wave, NGW = F.G * 8, lane = FLANE;
    const float* qn = F.a->in[I_QN]; const float* kn = F.a->in[I_KN];
    const f32x4 q0 = *(const f32x4*)(qn + 8 * (lane & 7)), q1 = *(const f32x4*)(qn + 8 * (lane & 7) + 4);
    const f32x4 k0 = *(const f32x4*)(kn + 8 * (lane & 7)), k1 = *(const f32x4*)(kn + 8 * (lane & 7) + 4);
    for (int r0 = gw; r0 < NLAT + NTOK; r0 += 4 * NGW) {
        u32x4* p[4]; u32x4 raw[4]; bool isq[4], ok[4];
#pragma unroll
        for (int e = 0; e < 4; ++e) { const int r = r0 + e * NGW; ok[e] = r < NLAT + NTOK; const int rr = ok[e] ? r : r0; isq[e] = rr < NLAT;
            p[e] = (u32x4*)(isq[e] ? WSP(bf16_t, B_Q1) + (size_t)rr * 512 : WSP(bf16_t, B_K1) + (size_t)(rr - NLAT) * 512) + lane; raw[e] = *p[e]; }
#pragma unroll
        for (int e = 0; e < 4; ++e) {
            const unsigned rw[4] = {raw[e].x, raw[e].y, raw[e].z, raw[e].w};
            float v[8]; float ss = 0.f;
#pragma unroll
            for (int t = 0; t < 4; ++t) { v[2 * t] = bf2f(rw[t] & 0xffffu); v[2 * t + 1] = bf2f(rw[t] >> 16); ss += v[2 * t] * v[2 * t] + v[2 * t + 1] * v[2 * t + 1]; }
            ss += __shfl_xor(ss, 1); ss += __shfl_xor(ss, 2); ss += __shfl_xor(ss, 4);
            const float rinv = rsqrtf(ss * (1.f / 64.f) + EPS) * (isq[e] ? 0.125f : 1.f);
            const f32x4 n0 = isq[e] ? q0 : k0, n1 = isq[e] ? q1 : k1;
            u32x4 o; o.x = pk2(v[0] * rinv * n0[0], v[1] * rinv * n0[1]); o.y = pk2(v[2] * rinv * n0[2], v[3] * rinv * n0[3]);
            o.z = pk2(v[4] * rinv * n1[0], v[5] * rinv * n1[1]); o.w = pk2(v[6] * rinv * n1[2], v[7] * rinv * n1[3]);
            if (ok[e]) *p[e] = o;
        }
    }
}
constexpr int NA_KC_PITCH = 72;
constexpr int NA_VC_PITCH = 264;
struct NaKV { bf16x8 k[2][2]; u32x2 v[4][2]; };
__device__ __forceinline__ void na_load_local(NaKV& f, const bf16_t* K1, const bf16_t* VT1, size_t krow0, const bf16_t* vbase, int h, int fr, int fq) {
#pragma unroll
    for (int x = 0; x < 2; ++x)
#pragma unroll
        for (int ks = 0; ks < 2; ++ks) f.k[x][ks] = *(const bf16x8*)(K1 + (krow0 + 16 * x + fr) * 512 + h * 64 + 32 * ks + 8 * fq);
#pragma unroll
    for (int dt = 0; dt < 4; ++dt) { const bf16_t* vr = vbase + (size_t)(16 * dt + fr) * 8192 + 4 * fq; f.v[dt][0] = *(const u32x2*)vr; f.v[dt][1] = *(const u32x2*)(vr + 16); }
}
__device__ __forceinline__ void na_unit(const Frame& F, int u, bool stage) {
    const int b = u >> 8, h = (u >> 5) & 7, rq = u & 31;
    const int rp = 2 * rq + (F.wave >> 2), jb = F.wave & 3, lane = FLANE, fr = lane & 15, fq = lane >> 4;
    LAS bf16_t* kc = (LAS bf16_t*)F.lds;
    LAS bf16_t* vc = kc + 256 * NA_KC_PITCH;
    LAS float* rpb = (LAS float*)(vc + 64 * NA_VC_PITCH);
    const bf16_t* K1 = WSP(bf16_t, B_K1); const bf16_t* VT1 = WSP(bf16_t, B_VT1);
    if (stage) {
        __syncthreads();
        for (int i = FTID; i < 465; i += 512) rpb[i] = F.a->in[I_RPB][h * 465 + i];
        for (int i = FTID; i < 256 * 8; i += 512) { const int key = i >> 3, c8 = i & 7; *(LAS u32x4*)(kc + key * NA_KC_PITCH + 8 * c8) = *(const u32x4*)(K1 + (size_t)(b * 256 + key) * 512 + h * 64 + 8 * c8); }
        const bf16_t* vsrc = VT1 + (size_t)NB * 8 * 64 * 8192 + (size_t)(b * 8 + h) * 64 * 256;
        for (int i = FTID; i < 64 * 32; i += 512) { const int dh = i >> 5, c8 = i & 31; *(LAS u32x4*)(vc + dh * NA_VC_PITCH + 8 * c8) = *(const u32x4*)(vsrc + dh * 256 + 8 * c8); }
        __syncthreads();
    }
    const int qc = 16 * jb + fr;
    const int kstart = jb == 0 ? 0 : (jb == 1 ? 8 : (jb == 2 ? 24 : 32)), qstart = min(max(qc - 8, 0), 48);
    bf16x8 Bq[2][2];
    int r0[2];
#pragma unroll
    for (int X = 0; X < 2; ++X) { const int r = 2 * rp + X; r0[X] = min(max(r - 4, 0), 120);
#pragma unroll
        for (int ks = 0; ks < 2; ++ks) Bq[X][ks] = *(const bf16x8*)(WSP(bf16_t, B_Q1) + (size_t)(b * 8192 + r * 64 + qc) * 512 + h * 64 + 32 * ks + 8 * fq); }
    f32x4 acc[2][4];
#pragma unroll
    for (int X = 0; X < 2; ++X)
#pragma unroll
        for (int dt = 0; dt < 4; ++dt) acc[X][dt] = (f32x4){0.f, 0.f, 0.f, 0.f};
    float lsum[2] = {0.f, 0.f};
    const int krlo = r0[0], krhi = r0[1] + 7;
    const bf16_t* vloc = VT1 + (size_t)(b * 8 + h) * 64 * 8192 + kstart;
    const size_t kloc = (size_t)(NCTX + b * 8192 + kstart);
    NaKV cur, nxt;
    na_load_local(cur, K1, VT1, kloc + (size_t)krlo * 64, vloc + krlo * 64, h, fr, fq);
#pragma unroll 1
    for (int s = 0; s < 9; ++s) {
        const int kr = krlo + s;
        if (kr < krhi) na_load_local(nxt, K1, VT1, kloc + (size_t)(kr + 1) * 64, vloc + (kr + 1) * 64, h, fr, fq);
        if (s < 8) {
            const int it = s;
            bf16x8 kf[2][2], vf[4];
#pragma unroll
            for (int x = 0; x < 2; ++x)
#pragma unroll
                for (int ks = 0; ks < 2; ++ks) kf[x][ks] = *(const LAS bf16x8*)(kc + (32 * it + 16 * x + fr) * NA_KC_PITCH + 32 * ks + 8 * fq);
#pragma unroll
            for (int dt = 0; dt < 4; ++dt) { const LAS bf16_t* vr = vc + (16 * dt + fr) * NA_VC_PITCH + 32 * it + 4 * fq; const u32x2 lo = *(const LAS u32x2*)vr, hi = *(const LAS u32x2*)(vr + 16);
                vf[dt] = __builtin_bit_cast(bf16x8, (u32x4){lo.x, lo.y, hi.x, hi.y}); }
#pragma unroll
            for (int X = 0; X < 2; ++X) {
                f32x4 st[2];
#pragma unroll
                for (int x = 0; x < 2; ++x) {
                    f32x4 a4 = (f32x4){0.f, 0.f, 0.f, 0.f};
                    a4 = __builtin_amdgcn_mfma_f32_16x16x32_bf16(kf[x][0], Bq[X][0], a4, 0, 0, 0);
                    a4 = __builtin_amdgcn_mfma_f32_16x16x32_bf16(kf[x][1], Bq[X][1], a4, 0, 0, 0);
#pragma unroll
                    for (int i = 0; i < 4; ++i) { const float p = __expf(a4[i]); a4[i] = p; lsum[X] += p; }
                    st[x] = a4;
                }
                const bf16x8 P = __builtin_bit_cast(bf16x8, pack8(st[0], st[1]));
#pragma unroll
                for (int dt = 0; dt < 4; ++dt) acc[X][dt] = __builtin_amdgcn_mfma_f32_16x16x32_bf16(vf[dt], P, acc[X][dt], 0, 0, 0);
            }
        }
        if (kr <= krhi) {
#pragma unroll
            for (int X = 0; X < 2; ++X) {
                const int r = 2 * rp + X;
                if (kr >= r0[X] && kr < r0[X] + 8) {
                    f32x4 st[2];
#pragma unroll
                    for (int x = 0; x < 2; ++x) {
                        f32x4 a4 = (f32x4){0.f, 0.f, 0.f, 0.f};
                        a4 = __builtin_amdgcn_mfma_f32_16x16x32_bf16(cur.k[x][0], Bq[X][0], a4, 0, 0, 0);
                        a4 = __builtin_amdgcn_mfma_f32_16x16x32_bf16(cur.k[x][1], Bq[X][1], a4, 0, 0, 0);
#pragma unroll
                        for (int i = 0; i < 4; ++i) {
                            const int kcn = kstart + 16 * x + 4 * fq + i; const float vm = (kcn >= qstart && kcn < qstart + 16) ? 1.f : 0.f;
                            const int ci = min(max(kcn - qc + 15, 0), 30), ri = kr - r + 7;
                            const float p = __expf(a4[i] + rpb[ri * 31 + ci]) * vm;
                            a4[i] = p; lsum[X] += p;
                        }
                        st[x] = a4;
                    }
                    const bf16x8 P = __builtin_bit_cast(bf16x8, pack8(st[0], st[1]));
#pragma unroll
                    for (int dt = 0; dt < 4; ++dt)
                        acc[X][dt] = __builtin_amdgcn_mfma_f32_16x16x32_bf16(__builtin_bit_cast(bf16x8, (u32x4){cur.v[dt][0].x, cur.v[dt][0].y, cur.v[dt][1].x, cur.v[dt][1].y}), P, acc[X][dt], 0, 0, 0);
                }
            }
        }
        cur = nxt;
    }
#pragma unroll
    for (int X = 0; X < 2; ++X) {
        float ls = lsum[X]; ls += __shfl_xor(ls, 16); ls += __shfl_xor(ls, 32);
        const float inv = 1.f / ls;
        bf16_t* o = WSP(bf16_t, B_MIX1) + (size_t)(b * 8192 + (2 * rp + X) * 64 + qc) * 1024 + h * 64 + 4 * fq;
#pragma unroll
        for (int dt = 0; dt < 4; ++dt) { u32x2 w; w.x = pk2(acc[X][dt][0] * inv, acc[X][dt][1] * inv); w.y = pk2(acc[X][dt][2] * inv, acc[X][dt][3] * inv); *(u32x2*)(o + 16 * dt) = w; }
    }
}
constexpr int NPHASE = 22;
constexpr int CW_BAR = 4096;
#ifndef N_LAUNCH_SPLIT
#define N_LAUNCH_SPLIT 0
#endif


__global__ void __launch_bounds__(512, 2) fwd_kernel(Args args) {
    extern __shared__ __attribute__((aligned(16))) unsigned char lds_raw[];
    Frame F;
    F.lds = (LAS unsigned char*)lds_raw; F.a = &args; F.ws = args.ws;
    F.wave = __builtin_amdgcn_readfirstlane(FTID >> 6); F.G = gridDim.x; F.bid = blockIdx.x;
    volatile LAS unsigned* st = (volatile LAS unsigned*)(F.lds + LDSCTL_OFF);
    if (FTID < 16) st[FTID] = 0u;
    __syncthreads();
    const int lo = args.ph_lo, hi = args.ph_hi, sub = args.sub;
    XcdBarrier bar; bar.bar = (unsigned*)(F.ws + M_CTL) + CW_BAR + args.li * XCD_BAR_WORDS; bar.x = 0; bar.st = st;
    if (hi - lo > 1) bar = xcd_barrier_post((unsigned*)(F.ws + M_CTL) + CW_BAR + args.li * XCD_BAR_WORDS, st);
#ifdef ONLY_PHASE
#define IN(k) ((k) == ONLY_PHASE && lo <= (k) && (k) < hi)
#else
#define IN(k) (lo <= (k) && (k) < hi)
#endif
#define SEAM(k) do { if (IN(k) && IN((k) + 1)) xcd_barrier(bar); } while (0)
    const char* ws = (const char*)F.ws;

    if (IN(0)) { phase0(F); } SEAM(0);
    if (sub >= 100 && hi - lo > 1) for (int i = 100; i < sub; ++i) xcd_barrier(bar);
    if (IN(1)) { phase1_norm0(F); } SEAM(1);
    if (IN(2)) {
        EpiIn0 E{WSP(bf16_t, B_QK), WSP(bf16_t, B_VT), WSP(bf16_t, B_G), WSP(bf16_t, B_AS5), WSP(bf16_t, B_LA), args.in[I_BA]};
        SchedDense S; S.ord.init(NTOK / 256, 10, F.G, F.bid); S.A = ws + B_ABUF; S.Bt = ws + W_IN0; S.atile = (size_t)256 * 1024 * 2; S.btile = (size_t)256 * 1024 * 2; S.pm_off = 0;
        g8::gemm_phase<EpiIn0, SchedDense, false>(F.lds, 1024, 1024, S, E);
    } SEAM(2);
    if (IN(3)) {
        if (sub != 2) for (int u = F.bid; u < GNCH; u += F.G) gla_c1_unit(F, u);
        __syncthreads();
        if (sub != 1) {
        EpiS1 E{WSP(float, B_ZS5)};
        const int nx = GNCH % F.G; SchedS5 S{ws + B_AS5, ws + W_S1, 1, S5KU, F.G - nx, F.bid - nx};
        g8::gemm_phase<EpiS1, SchedS5, false>(F.lds, S5K, S5KU, S, E);
        }
    } SEAM(3);
    if (IN(4)) { if (sub != 2) gla_scan(F); if (sub != 1) s5_scan(F); } SEAM(4);
    if (IN(5)) {
#if !defined(SUB) || SUB == 1
        if (sub != 2) for (int u = F.bid; u < GNCH; u += F.G) gla_c3_unit(F, u, sub >> 4);
        __syncthreads();
#endif
#if !defined(SUB) || SUB == 2
        if (sub != 1) {
        EpiS3 E{WSP(bf16_t, B_YG)};
        const int nx = GNCH % F.G; SchedS5 S{ws + B_AS5, ws + W_S3, 2, S5K, F.G - nx, F.bid - nx};
        g8::gemm_phase<EpiS3, SchedS5, false>(F.lds, S5K, S5K, S, E);
        }
#endif
    } SEAM(5);
    if (IN(6)) {
        EpiGlu E{WSP(bf16_t, B_YG), WSP(bf16_t, B_MIX0)};
        SchedDense S; S.ord.init(NTOK / 256, 2, F.G, F.bid); S.A = ws + B_YG; S.Bt = ws + W_GLU; S.atile = (size_t)256 * 512 * 2; S.btile = (size_t)256 * 512 * 2; S.pm_off = 0;
        g8::gemm_phase<EpiGlu, SchedDense, false>(F.lds, 512, 512, S, E);
    } SEAM(6);
    if (IN(7)) {
        EpiOut E{args.in[I_X], args.in[I_CTX], WSP(bf16_t, B_X1), WSP(float, M_MOD), 0};
        SchedDense S; S.ord.init(NTOK / 256, 4, F.G, F.bid); S.A = ws + B_MIX0; S.Bt = ws + W_OUT0; S.atile = (size_t)256 * 1024 * 2; S.btile = (size_t)256 * 1024 * 2; S.pm_off = 0;
        g8::gemm_phase<EpiOut, SchedDense, false>(F.lds, 1024, 1024, S, E);
        {
            const int tl7 = S.ord.nwg % F.G, nx7 = 2 * tl7 <= F.G ? 2 * tl7 : tl7, nb = F.G - nx7; __syncthreads();
            LAS float* scr = (LAS float*)(F.lds + F.wave * 16384);
            if (nb >= 128) { if (F.bid >= nx7) for (int it = (F.bid - nx7) * 8 + F.wave; it < MOE_ITEMS; it += nb * 8) moe_conv_item(F, 0, it, scr); }
            else for (int it = F.bid * 8 + F.wave; it < MOE_ITEMS; it += F.G * 8) moe_conv_item(F, 0, it, scr);
        }
    } SEAM(7);
    if (IN(8)) { router_phase(F, 0); } SEAM(8);
    if (IN(9)) { placement_phase(F, 0); } SEAM(9);
    if (IN(10)) {
        EpiM1 E{WSP(bf16_t, B_ACT)};
        SchedMoe S{WSP(int, M_TILES), WSP(int, M_TOKBUF), ws + B_ABUF, ws + W_M13, (size_t)1024 * 1024 * 2, (size_t)256 * 1024 * 2, 0, F.G, F.bid, 1};
        g8::gemm_phase<EpiM1, SchedMoe, true>(F.lds, 1024, 1024, S, E);
    } SEAM(10);
    if (IN(11)) {
        EpiM2 E{WSP(bf16_t, B_YB)};
        SchedMoe S{WSP(int, M_TILES), WSP(int, M_TOKBUF), ws + B_ACT, ws + W_M2, (size_t)1024 * 512 * 2, (size_t)256 * 512 * 2, (size_t)256 * 512 * 2, F.G, F.bid, 0};
        g8::gemm_phase<EpiM2, SchedMoe, false>(F.lds, 512, 512, S, E);
    } SEAM(11);
    if (IN(12)) {
        if (sub != 2) combine_norm1_phase(F);
        if (sub != 1) for (int u = F.bid; u < 256; u += F.G) hf_unit(F, u);
    } SEAM(12);
    if (IN(13)) {
        EpiIn1 E{WSP(bf16_t, B_Q1), WSP(bf16_t, B_K1), WSP(bf16_t, B_VT1), WSP(bf16_t, B_ZHT)};
        SchedIn1 S; S.ord.init(NLAT / 256, 12, F.G, F.bid); S.A = ws + B_ABUF; S.Bt = ws + W_IN1; S.G = F.G; S.c = F.bid;
        if (sub != 2) g8::gemm_phase<EpiIn1, SchedIn1, false>(F.lds, 1024, 1024, S, E);
        if (sub != 1) for (int u = F.bid; u < 512; u += F.G) kf_unit(F, u);
    } SEAM(13);
    if (IN(14)) {
#if !defined(SUB) || SUB == 1
        if (sub != 2) qknorm_phase(F);
#endif
#if !defined(SUB) || SUB == 2
        if (sub != 1) for (int u = F.bid; u < 1024; u += F.G) hyconv_unit(F, u, sub >> 4);
#endif
    } SEAM(14);
    if (IN(15)) {
#if !defined(SUB) || SUB == 1
        if (sub != 2) { const int per = (1024 + F.G - 1) / F.G; for (int k = 0; k < per; ++k) { const int u = F.bid * per + k; if (u < 1024) na_unit(F, u, k == 0 || (u & 31) == 0); } }
        __syncthreads();
#endif
#if !defined(SUB) || SUB == 2
        if (sub != 1) {
        LAS bf16_t* scr = (LAS bf16_t*)(F.lds + F.wave * 16384);
        for (int it = F.bid * 8 + F.wave; it < 8 * 512; it += F.G * 8) hy_transpose_item(F, it, scr);
        }
#endif
    } SEAM(15);
    if (IN(16)) {
        EpiOut E{args.in[I_X], args.in[I_CTX], WSP(bf16_t, B_X1), WSP(float, M_MOD) + 5 * 6144, 1};
        SchedDense S; S.ord.init(NLAT / 256, 4, F.G, F.bid); S.A = ws + B_MIX1; S.Bt = ws + W_OUT1; S.atile = (size_t)256 * 1024 * 2; S.btile = (size_t)256 * 1024 * 2; S.pm_off = 4;
        g8::gemm_phase<EpiOut, SchedDense, false>(F.lds, 1024, 1024, S, E);
    } SEAM(16);
    if (IN(17)) {
        if (sub != 2) router_phase(F, 1);
        __syncthreads();
        if (sub != 1) {
        LAS float* scr = (LAS float*)(F.lds + F.wave * 16384);
        for (int it = F.bid * 8 + F.wave; it < MOE_ITEMS; it += F.G * 8) moe_conv_item(F, 1, it, scr);
        }
    } SEAM(17);
    if (IN(18)) { placement_phase(F, 1); } SEAM(18);
    if (IN(19)) {
        EpiM1 E{WSP(bf16_t, B_ACT)};
        SchedMoe S{WSP(int, M_TILES), WSP(int, M_TOKBUF), ws + B_ABUF, ws + W_M13, (size_t)1024 * 1024 * 2, (size_t)256 * 1024 * 2, 0, F.G, F.bid, 1};
        g8::gemm_phase<EpiM1, SchedMoe, true>(F.lds, 1024, 1024, S, E);
    } SEAM(19);
    if (IN(20)) {
        EpiM2 E{WSP(bf16_t, B_YB)};
        SchedMoe S{WSP(int, M_TILES), WSP(int, M_TOKBUF), ws + B_ACT, ws + W_M2, (size_t)1024 * 512 * 2, (size_t)256 * 512 * 2, (size_t)256 * 512 * 2, F.G, F.bid, 0};
        g8::gemm_phase<EpiM2, SchedMoe, false>(F.lds, 512, 512, S, E);
    } SEAM(20);
    if (IN(21)) { final_phase(F); }
#undef IN
#undef SEAM
}

extern "C" void kernel_launch(void* const* d_in, const int* in_sizes, int n_in, void* d_out, int out_size, void* d_ws, size_t ws_size, hipStream_t stream) {
    static int grid = 0;
    if (grid == 0) {
        if (n_in != 43 || out_size != NLAT * D || ws_size < WS_END) { fprintf(stderr, "kernel_launch: unexpected shapes (n_in %d out %d ws %zu)\n", n_in, out_size, ws_size); grid = -1; return; }
        int dev = 0, cus = 0, per_cu = 0;
        if (hipGetDevice(&dev) != hipSuccess || hipDeviceGetAttribute(&cus, hipDeviceAttributeMultiprocessorCount, dev) != hipSuccess) { grid = -1; return; }
        if (hipFuncSetAttribute((const void*)fwd_kernel, hipFuncAttributeMaxDynamicSharedMemorySize, LDS_BYTES) != hipSuccess) { fprintf(stderr, "kernel_launch: hipFuncSetAttribute failed\n"); grid = -1; return; }
        if (hipOccupancyMaxActiveBlocksPerMultiprocessor(&per_cu, (const void*)fwd_kernel, 512, LDS_BYTES) != hipSuccess || per_cu < 1) { fprintf(stderr, "kernel_launch: occupancy query says %d\n", per_cu); per_cu = 1; }
        (void)hipGetLastError();
        grid = cus < 256 ? cus : 256;
    }
    if (grid < 0) return;
    (void)hipMemsetAsync((char*)d_ws + M_CTL, 0, CTL_BYTES, stream);
    Args a{};
    for (int i = 0; i < 43; ++i) a.in[i] = (const float*)d_in[i];
    a.out = (float*)d_out; a.ws = (unsigned char*)d_ws;
#if N_LAUNCH_SPLIT
    a.sub = 0; a.li = 0;
    for (int p = 0; p < NPHASE; ++p) { a.ph_lo = p; a.ph_hi = p + 1; hipLaunchKernelGGL(fwd_kernel, dim3(grid), dim3(512), LDS_BYTES, stream, a); }
#elif defined(PROBE_BARRIERS)
    a.ph_lo = 0; a.ph_hi = NPHASE; a.sub = 100 + PROBE_BARRIERS; a.li = 0;
    { void* kargs[] = {&a}; hipLaunchCooperativeKernel((const void*)fwd_kernel, dim3(grid), dim3(512), kargs, LDS_BYTES, stream); }
#elif defined(PROBE_PHASE)
    { void* kargs[] = {&a};
      if (PROBE_PHASE > 0) { a.ph_lo = 0; a.ph_hi = PROBE_PHASE; a.sub = 0; a.li = 0; hipLaunchCooperativeKernel((const void*)fwd_kernel, dim3(grid), dim3(512), kargs, LDS_BYTES, stream); }
      for (int r = 0; r < PROBE_EXTRA; ++r) { a.ph_lo = PROBE_PHASE; a.ph_hi = PROBE_PHASE + 1; a.sub = PROBE_SUB; a.li = 1;
        hipLaunchCooperativeKernel((const void*)fwd_kernel, dim3(grid), dim3(512), kargs, LDS_BYTES, stream); }
      a.ph_lo = PROBE_PHASE; a.ph_hi = NPHASE; a.sub = 0; a.li = 2;
      hipLaunchCooperativeKernel((const void*)fwd_kernel, dim3(grid), dim3(512), kargs, LDS_BYTES, stream); }
#else
    a.ph_lo = 0; a.ph_hi = NPHASE; a.sub = 0; a.li = 0;
    void* kargs[] = {&a};
    hipError_t e = hipLaunchCooperativeKernel((const void*)fwd_kernel, dim3(grid), dim3(512), kargs, LDS_BYTES, stream);
    if (e != hipSuccess) fprintf(stderr, "cooperative launch failed: %s (grid %d)\n", hipGetErrorString(e), grid);
#endif
}
```

```cpp
#include <hip/hip_runtime.h>
#include <hip/hip_cooperative_groups.h>
#include <cstdio>
#include <cstdint>
#include <cmath>

#define LAS __attribute__((address_space(3)))
#define GAS __attribute__((address_space(1)))
typedef unsigned short bf16_t;
typedef short bf16x8 __attribute__((ext_vector_type(8)));
typedef short bf16x4 __attribute__((ext_vector_type(4)));
typedef float f32x4 __attribute__((ext_vector_type(4)));
typedef float f32x2 __attribute__((ext_vector_type(2)));
typedef unsigned u32x4 __attribute__((ext_vector_type(4)));
typedef unsigned u32x2 __attribute__((ext_vector_type(2)));

constexpr int D = 1024, NB = 4, SEQ = 8192, CTX = 256;
constexpr int NCTX = NB * CTX;
constexpr int NLAT = NB * SEQ;
constexpr int NTOK = NCTX + NLAT;
constexpr int NEXP = 32;
constexpr float EPS = 1e-6f;
constexpr int S5TC = 32;
constexpr int S5KU = S5TC * 16;
constexpr int S5K = S5KU + 256;
constexpr int S5ROWS = 1280;
constexpr int S5NCH = NTOK / S5TC;
constexpr int GCH = 64;
constexpr int GNCH = NTOK / GCH;
constexpr int GSEQ = (CTX + SEQ) / GCH;
constexpr int MOE_TILES_MAX = 296;
constexpr int FFTN = 16384;

constexpr size_t MiB = 1u << 20;
constexpr size_t WS_MISC = 0;
constexpr size_t WS_WSMALL = 8 * MiB;
constexpr size_t WS_WMOE = 56 * MiB;
constexpr size_t WS_ABUF = 152 * MiB;
constexpr size_t WS_X1 = 218 * MiB;
constexpr size_t WS_R3 = 350 * MiB;
constexpr size_t WS_END = 576 * MiB;
constexpr size_t W_IN0 = WS_WSMALL;
constexpr size_t W_OUT0 = W_IN0 + 2560 * 1024 * 2;
constexpr size_t W_GLU = W_OUT0 + 1024 * 1024 * 2;
constexpr size_t W_IN1 = W_GLU + 512 * 512 * 2;
constexpr size_t W_OUT1 = W_IN1 + 3072 * 1024 * 2;
constexpr size_t W_S3 = W_OUT1 + 1024 * 1024 * 2;
constexpr size_t W_S1 = W_S3 + (size_t)32 * 512 * 768 * 2;
static_assert(W_S1 + (size_t)32 * 256 * 512 * 2 <= WS_WMOE, "wsmall");
constexpr size_t W_M13 = WS_WMOE;
constexpr size_t W_M2 = WS_WMOE + (size_t)32 * 1024 * 1024 * 2;
constexpr size_t W_M13B = WS_X1 + 66 * MiB;
constexpr size_t B_HF = WS_WMOE;
constexpr size_t B_MIX1 = WS_WMOE;
constexpr size_t B_Q1 = WS_WMOE + 64 * MiB;
constexpr size_t B_ABUF = WS_ABUF;
constexpr size_t B_ZS5 = WS_ABUF;
constexpr size_t B_YG = WS_ABUF;
constexpr size_t B_HYT = WS_ABUF;
constexpr size_t B_X1 = WS_X1;
constexpr size_t B_QK = WS_X1;
constexpr size_t B_VT = WS_X1 + 33 * MiB;
constexpr size_t B_G = WS_X1 + 66 * MiB;
constexpr size_t B_DEC = WS_X1 + 102 * MiB;
constexpr size_t B_AS5 = WS_R3;
constexpr size_t B_UPD = WS_R3 + 60 * MiB;
constexpr size_t B_MIX0 = WS_R3 + 126 * MiB;
constexpr size_t B_LA = WS_R3 + 192 * MiB;
constexpr size_t B_ACT = WS_R3;
constexpr size_t B_YB = WS_R3 + 74 * MiB;
constexpr size_t B_KF = WS_R3;
constexpr size_t B_K1 = WS_R3 + 64 * MiB;
constexpr size_t B_VT1 = WS_R3 + 97 * MiB;
constexpr size_t B_ZHT = WS_R3 + 130 * MiB;
static_assert(W_M13B + 64 * MiB <= WS_R3 && B_LA + (size_t)NTOK * 512 * 2 <= WS_END && B_ZHT + (size_t)1536 * 32768 * 2 <= WS_END && B_YB + (size_t)MOE_TILES_MAX * 256 * 1024 * 2 <= WS_END && B_MIX0 + (size_t)NTOK * 1024 * 2 <= WS_END, "arena");
constexpr size_t M_CTL = 0;
constexpr size_t CTL_BYTES = 65536;
constexpr size_t M_MOD = 65536;
constexpr size_t M_TW = M_MOD + 245760;
constexpr size_t M_ROPE = M_TW + 131072;
constexpr size_t M_H3 = M_ROPE + 16384;
constexpr size_t M_ROUTE = M_H3 + 2097152;
constexpr size_t M_HIST = M_ROUTE + 1081344;
constexpr size_t M_TOKBUF = M_HIST + 32768;
constexpr size_t M_GATEBUF = M_TOKBUF + 303104;
constexpr size_t M_TILES = M_GATEBUF + 303104;
constexpr size_t M_KERN = 5 * MiB;
static_assert(M_TILES + 4096 <= M_KERN && M_KERN + 2 * MiB <= 8 * MiB, "misc");

__device__ __forceinline__ float bf2f(unsigned v) { return __uint_as_float(v << 16); }
__device__ __forceinline__ unsigned f2bf(float f) { return (unsigned)__builtin_bit_cast(unsigned short, (__bf16)f); }
typedef __bf16 bf16x2_t __attribute__((ext_vector_type(2)));
__device__ __forceinline__ unsigned pk2(float lo, float hi) { const f32x2 v = {lo, hi}; return __builtin_bit_cast(unsigned, __builtin_convertvector(v, bf16x2_t)); }
__device__ __forceinline__ float wave_sum(float v) {
#pragma unroll
    for (int o = 1; o < 64; o <<= 1) v += __shfl_xor(v, o);
    return v;
}
__device__ __forceinline__ float silu_f(float x) { return x * __builtin_amdgcn_rcpf(1.f + __expf(-x)); }
__device__ __forceinline__ float sigmoid_f(float x) { return __builtin_amdgcn_rcpf(1.f + __expf(-x)); }
__device__ __forceinline__ float gelu_tanh_f(float x) { const float u = 0.7978845608028654f * (x + 0.044715f * x * x * x); return x * __builtin_amdgcn_rcpf(1.f + __expf(-2.f * u)); }
__device__ __forceinline__ float logsigmoid_f(float x) { return fminf(x, 0.f) - __logf(1.f + __expf(-fabsf(x))); }
#define LDS_WAIT() asm volatile("s_waitcnt lgkmcnt(0)" ::: "memory")
#define VM_WAIT() asm volatile("s_waitcnt vmcnt(0)" ::: "memory")
#define LDS_BARRIER() do { asm volatile("s_waitcnt lgkmcnt(0)" ::: "memory"); __builtin_amdgcn_s_barrier(); asm volatile("" ::: "memory"); } while (0)
namespace g8 {
constexpr int BM = 256, BK = 64, HALF = 128, HTB = HALF * BK * 2, STAGE_BYTES = 8 * HTB;
__host__ __device__ __forceinline__ int lds_byte(int r, int c) { const int st = (r >> 4) * 2 + (c >> 5), rr = r & 15, cc = c & 31, ob = rr * 64 + cc * 2; return st * 1024 + (ob ^ (((ob >> 9) & 1) << 5)); }
__host__ __device__ __forceinline__ void stage_rc(int b, int& R, int& C) { const int st = b / 1024, sb = b % 1024, swz = sb ^ (((sb >> 9) & 1) << 5); R = (st >> 1) * 16 + swz / 64; C = (st & 1) * 32 + (swz % 64) / 2; }
__host__ __device__ __forceinline__ int perm32(int rho) { const int n = rho >> 4, i = rho & 15; return 8 * (i >> 2) + 4 * n + (i & 3); }

struct Unit { const char* a; const char* b; const int* rows; int pm, pn, aux, half; };

template <class Epi, class Sched, bool GATHER>
__device__ __forceinline__ void gemm_phase(LAS unsigned char* lds, const int lda, const int K, const Sched& S, const Epi& E) {
    const int tid = threadIdx.x, wid = __builtin_amdgcn_readfirstlane(tid >> 6), lane = tid & 63, wr = wid >> 2, wc = wid & 3, fr = lane & 15, fq = lane >> 4;
    const int nt = K / BK;
    int sR[2], sC[2];
    unsigned voffB[2];
#pragma unroll
    for (int i = 0; i < 2; ++i) { stage_rc(tid * 16 + i * 8192, sR[i], sC[i]); const int Rb = Epi::PERM ? ((sR[i] & ~31) + perm32(sR[i] & 31)) : sR[i]; voffB[i] = (unsigned)(Rb * K + sC[i]) * 2u; }
    unsigned vAc[2][2], vAn[2][2];
    const size_t kstep = (size_t)(BK * 2);
    const size_t hstepB = (size_t)HALF * K * 2;
    const unsigned ldsw = (unsigned)wid * 1024u;
    const int aoff = lds_byte(wr * 64 + fr, fq * 8), boff = lds_byte(wc * 32 + fr, fq * 8);
#define G8_SA(b, h) (((b) * 2 + (h)) * HTB)
#define G8_SB(b, h) ((4 + (b) * 2 + (h)) * HTB)
#define G8_STAGE_B(bufoff, gbase) do { _Pragma("unroll") for (int _i = 0; _i < 2; ++_i) \
        __builtin_amdgcn_global_load_lds((const unsigned*)((const char*)(gbase) + voffB[_i]), (LAS unsigned*)(lds + (bufoff) + ldsw + _i * 8192), 16, 0, 0); } while (0)
#define G8_STAGE_A(bufoff, gbase, h, NX) do { _Pragma("unroll") for (int _i = 0; _i < 2; ++_i) \
        __builtin_amdgcn_global_load_lds((const unsigned*)((const char*)(gbase) + ((NX) ? vAn[h][_i] : vAc[h][_i])), (LAS unsigned*)(lds + (bufoff) + ldsw + _i * 8192), 16, 0, 0); } while (0)
#define G8_LDA(dst, b, h) do { _Pragma("unroll") for (int m = 0; m < 4; ++m) _Pragma("unroll") for (int k = 0; k < 2; ++k) dst[m][k] = *(const LAS bf16x8*)(lds + G8_SA(b, h) + aoff + m * 2048 + k * 1024); } while (0)
#define G8_LDB(dst, b, h) do { _Pragma("unroll") for (int n = 0; n < 2; ++n) _Pragma("unroll") for (int k = 0; k < 2; ++k) dst[n][k] = *(const LAS bf16x8*)(lds + G8_SB(b, h) + boff + n * 2048 + k * 1024); } while (0)
#define G8_MMA(ai, bj, At, Bt) do { __builtin_amdgcn_s_setprio(1); _Pragma("unroll") for (int m = 0; m < 4; ++m) _Pragma("unroll") for (int n = 0; n < 2; ++n) _Pragma("unroll") for (int k = 0; k < 2; ++k) \
        acc[ai][bj][m][n] = __builtin_amdgcn_mfma_f32_16x16x32_bf16(Bt[n][k], At[m][k], acc[ai][bj][m][n], 0, 0, 0); __builtin_amdgcn_s_setprio(0); } while (0)
#define G8_WAIT_V(n) asm volatile("s_waitcnt vmcnt(" #n ")" ::: "memory")
#define G8_WAIT_L(n) asm volatile("s_waitcnt lgkmcnt(" #n ")" ::: "memory")
#define G8_BAR __builtin_amdgcn_s_barrier()
#define G8_SCHED __builtin_amdgcn_sched_barrier(0)
#define G8_VA(dst, u) do { _Pragma("unroll") for (int _h = 0; _h < 2; ++_h) _Pragma("unroll") for (int _i = 0; _i < 2; ++_i) { \
        const int _row = GATHER ? (u).rows[sR[_i] + 128 * _h] : (sR[_i] + 128 * _h); dst[_h][_i] = (unsigned)(_row * lda + sC[_i]) * 2u; } } while (0)
    Unit cur, nxt; int ui = 0;
    if (!S.next(0, cur)) return;
    f32x4 acc[2][2][4][2];
#pragma unroll
    for (int a = 0; a < 2; ++a)
#pragma unroll
        for (int b = 0; b < 2; ++b)
#pragma unroll
            for (int m = 0; m < 4; ++m)
#pragma unroll
                for (int n = 0; n < 2; ++n) acc[a][b][m][n] = (f32x4){0.f, 0.f, 0.f, 0.f};
    bf16x8 At[4][2], B0[2][2], B1[2][2];
    G8_VA(vAc, cur);
#pragma unroll
    for (int _h = 0; _h < 2; ++_h)
#pragma unroll
        for (int _i = 0; _i < 2; ++_i) vAn[_h][_i] = vAc[_h][_i];
    const char* cA = cur.a; const char* cB = cur.b;
    {
        const char* a0 = cA; const char* a1p = cA + kstep;
        G8_STAGE_B(G8_SB(0, 0), cB); G8_STAGE_B(G8_SB(0, 1), cB + hstepB); G8_STAGE_A(G8_SA(0, 0), a0, 0, false); G8_STAGE_A(G8_SA(0, 1), a0, 1, false);
        if (wr == 1) G8_BAR;
        G8_WAIT_V(2); G8_BAR;
        G8_STAGE_B(G8_SB(1, 0), cB + kstep); G8_STAGE_A(G8_SA(1, 0), a1p, 0, false); G8_STAGE_B(G8_SB(1, 1), cB + hstepB + kstep);
        G8_WAIT_V(6); G8_BAR;
    }
    for (;;) {
        const bool has_next = S.next(ui + 1, nxt);
        if (GATHER) { if (has_next) { G8_VA(vAn, nxt); } }
        const char* nA = has_next ? nxt.a : cA; const char* nB = has_next ? nxt.b : cB;
        for (int t = 0; t < nt; t += 2) {
            const bool last = (t == nt - 2);
            const char* a1 = cA + (size_t)(t + 1) * kstep;
            const char* a2 = last ? nA : cA + (size_t)(t + 2) * kstep;
            const char* a3 = a2 + kstep;
            const char* b2 = last ? nB : cB + (size_t)(t + 2) * kstep;
            const char* b3 = b2 + kstep;
            const bool nx = GATHER ? (last && has_next) : false;
            G8_LDB(B0, 0, 0); G8_LDB(B1, 0, 1); G8_SCHED; G8_LDA(At, 0, 0); G8_STAGE_A(G8_SA(1, 1), a1, 1, false);
            G8_WAIT_V(8); G8_WAIT_L(0); G8_BAR; if (cur.half != 1) { G8_MMA(0, 0, At, B0); G8_MMA(0, 1, At, B1); } G8_BAR; G8_SCHED;
            G8_LDA(At, 0, 1); G8_STAGE_B(G8_SB(0, 0), b2); G8_STAGE_B(G8_SB(0, 1), b2 + hstepB); G8_STAGE_A(G8_SA(0, 0), a2, 0, nx);
            G8_WAIT_V(8); G8_WAIT_L(0); G8_BAR; if (cur.half != 0) { G8_MMA(1, 0, At, B0); G8_MMA(1, 1, At, B1); } G8_BAR; G8_SCHED;
            G8_LDB(B0, 1, 0); G8_LDB(B1, 1, 1); G8_SCHED; G8_LDA(At, 1, 0); G8_STAGE_A(G8_SA(0, 1), a2, 1, nx);
            G8_WAIT_V(8); G8_WAIT_L(0); G8_BAR; if (cur.half != 1) { G8_MMA(0, 0, At, B0); G8_MMA(0, 1, At, B1); } G8_BAR; G8_SCHED;
            G8_LDA(At, 1, 1); G8_STAGE_B(G8_SB(1, 0), b3); G8_STAGE_B(G8_SB(1, 1), b3 + hstepB); G8_STAGE_A(G8_SA(1, 0), a3, 0, nx);
            G8_WAIT_V(8); G8_WAIT_L(0); G8_BAR; if (cur.half != 0) { G8_MMA(1, 0, At, B0); G8_MMA(1, 1, At, B1); } G8_BAR; G8_SCHED;
        }
        if (wr == 0) G8_BAR;
        E(acc, cur, wr, wc, fr, fq);
        if (!has_next) break;
#pragma unroll
        for (int a = 0; a < 2; ++a)
#pragma unroll
            for (int b = 0; b < 2; ++b)
#pragma unroll
                for (int m = 0; m < 4; ++m)
#pragma unroll
                    for (int n = 0; n < 2; ++n) acc[a][b][m][n] = (f32x4){0.f, 0.f, 0.f, 0.f};
        cur = nxt; cA = nA; cB = nB; ++ui;
        if (GATHER) {
#pragma unroll
            for (int _h = 0; _h < 2; ++_h)
#pragma unroll
                for (int _i = 0; _i < 2; ++_i) vAc[_h][_i] = vAn[_h][_i];
        }
        if (wr == 1) G8_BAR;
    }
    G8_WAIT_V(0);
    G8_BAR;
#undef G8_SA
#undef G8_SB
#undef G8_STAGE_A
#undef G8_STAGE_B
#undef G8_LDA
#undef G8_LDB
#undef G8_MMA
#undef G8_WAIT_V
#undef G8_WAIT_L
#undef G8_BAR
#undef G8_SCHED
#undef G8_VA
}

struct DenseOrder {
    int nM, nN, nwg, G, c;
    __device__ __forceinline__ void init(int nM_, int nN_, int G_, int c_) { nM = nM_; nN = nN_; nwg = nM * nN; G = G_; c = c_; }
    __device__ __forceinline__ bool mapL(int L, int& pm, int& pn) const {
        if (L >= nwg) return false;
        int wgid = L; { const int q = nwg / 8, r = nwg % 8, xcd = wgid % 8, off = wgid / 8; wgid = (xcd < r ? xcd * (q + 1) : r * (q + 1) + (xcd - r) * q) + off; }
        const int nig = 8 * nN, gid = wgid / nig, fm = gid * 8, gsz = (nM - fm) < 8 ? (nM - fm) : 8;
        pm = fm + ((wgid % nig) % gsz); pn = (wgid % nig) / gsz; return true;
    }
};
__device__ __forceinline__ bool tail_split(int i, int G, int c, int U, int& L, int& half) {
    const int R = U / G, tail = U - R * G;
    if (c < 0) return false;
    if (i < R) { L = i * G + c; half = -1; return true; }
    if (i > R || tail == 0) return false;
    if (2 * tail <= G) { if (c >= 2 * tail) return false; L = R * G + (c >> 1); half = c & 1; return true; }
    if (c >= tail) return false;
    L = R * G + c; half = -1; return true;
}
}
using g8::Unit;
__device__ __forceinline__ u32x4 pack8(const f32x4 a, const f32x4 b) { u32x4 w; w.x = pk2(a[0], a[1]); w.y = pk2(a[2], a[3]); w.z = pk2(b[0], b[1]); w.w = pk2(b[2], b[3]); return w; }

__device__ __forceinline__ int tok_b5(int T) { return T < NCTX ? 4 : (T - NCTX) / SEQ; }
__device__ __forceinline__ int s5_row_of_chunk(int ch  ) { return ch >= NCTX / S5TC ? ch - NCTX / S5TC : 1024 + ch; }

struct EpiIn0 {
    static constexpr bool PERM = true;
    bf16_t *QK, *VT, *G, *AS5, *LA; const float* ba;
    __device__ __forceinline__ void operator()(const f32x4 (&acc)[2][2][4][2], const Unit& u, int wr, int wc, int fr, int fq) const {
#pragma unroll
        for (int ai = 0; ai < 2; ++ai)
#pragma unroll
            for (int m = 0; m < 4; ++m) {
                if (u.half >= 0 && u.half != ai) continue;
                const int T = u.pm * 256 + ai * 128 + wr * 64 + m * 16 + fr;
#pragma unroll
                for (int bj = 0; bj < 2; ++bj) {
                    const int c = u.pn * 256 + bj * 128 + wc * 32 + fq * 8;
                    const f32x4 v0 = acc[ai][bj][m][0], v1 = acc[ai][bj][m][1];
                    if (u.pn < 2) { *(u32x4*)(QK + (size_t)T * 512 + c) = pack8(v0, v1); }
                    else if (u.pn < 4) {
                        const int cc = u.pn * 256 + ai * 128 + wr * 64 + m * 16 + fr - 512, h = cc >> 7, dv = cc & 127;
                        const int Tq = u.pm * 256 + bj * 128 + wc * 32 + fq * 8, ch = Tq >> 6, t = Tq & 63;
                        *(u32x4*)(VT + ((size_t)(ch * 4 + h) * 128 + dv) * 64 + t) = pack8(v0, v1);
                    }
                    else if (u.pn < 6) { *(u32x4*)(G + (size_t)T * 512 + (c - 1024)) = pack8(v0, v1); }
                    else if (u.pn < 8) {
                        const int cc = c - 1536, g = cc >> 4, hh = cc & 15, nrow = s5_row_of_chunk(T >> 5), t = T & 31;
                        *(u32x4*)(AS5 + ((size_t)g * S5ROWS + nrow) * S5K + t * 16 + hh) = pack8(v0, v1);
                    }
                    else { const int cc = c - 2048; const f32x4 b0 = *(const f32x4*)(ba + cc), b1 = *(const f32x4*)(ba + cc + 4); f32x4 l0, l1;
#pragma unroll
                        for (int j = 0; j < 4; ++j) { l0[j] = fmaxf(logsigmoid_f(v0[j] + b0[j]) * (1.f / 16.f), -1.f); l1[j] = fmaxf(logsigmoid_f(v1[j] + b1[j]) * (1.f / 16.f), -1.f); }
                        *(u32x4*)(LA + (size_t)T * 512 + cc) = pack8(l0, l1); }
                }
            }
    }
};
struct EpiS1 {
    static constexpr bool PERM = false;
    float* Z;
    __device__ __forceinline__ void operator()(const f32x4 (&acc)[2][2][4][2], const Unit& u, int wr, int wc, int fr, int fq) const {
#pragma unroll
        for (int ai = 0; ai < 2; ++ai)
#pragma unroll
            for (int m = 0; m < 4; ++m) {
                if (u.half >= 0 && u.half != ai) continue;
                const int nrow = u.pm * 256 + ai * 128 + wr * 64 + m * 16 + fr;
                if (nrow < S5NCH) {
                    float* zr = Z + ((size_t)u.aux * S5ROWS + nrow) * 256;
#pragma unroll
                    for (int bj = 0; bj < 2; ++bj)
#pragma unroll
                        for (int n = 0; n < 2; ++n) *(f32x4*)(zr + bj * 128 + wc * 32 + n * 16 + fq * 4) = acc[ai][bj][m][n];
                }
            }
    }
};
struct EpiS3 {
    static constexpr bool PERM = true;
    bf16_t* YG;
    __device__ __forceinline__ void operator()(const f32x4 (&acc)[2][2][4][2], const Unit& u, int wr, int wc, int fr, int fq) const {
#pragma unroll
        for (int ai = 0; ai < 2; ++ai)
#pragma unroll
            for (int m = 0; m < 4; ++m) {
                if (u.half >= 0 && u.half != ai) continue;
                const int nrow = u.pm * 256 + ai * 128 + wr * 64 + m * 16 + fr;
                if (nrow < S5NCH) {
                    const int T0 = nrow < 1024 ? NCTX + nrow * S5TC : (nrow - 1024) * S5TC;
#pragma unroll
                    for (int bj = 0; bj < 2; ++bj) {
                        const int c = u.pn * 256 + bj * 128 + wc * 32 + fq * 8, t = c >> 4, hh = c & 15;
                        f32x4 v0 = acc[ai][bj][m][0], v1 = acc[ai][bj][m][1];
#pragma unroll
                        for (int j = 0; j < 4; ++j) { v0[j] = gelu_tanh_f(v0[j]); v1[j] = gelu_tanh_f(v1[j]); }
                        *(u32x4*)(YG + (size_t)(T0 + t) * 512 + u.aux * 16 + hh) = pack8(v0, v1);
                    }
                }
            }
    }
};
struct EpiGlu {
    static constexpr bool PERM = true;
    const bf16_t* YG; bf16_t* MIX;
    __device__ __forceinline__ void operator()(const f32x4 (&acc)[2][2][4][2], const Unit& u, int wr, int wc, int fr, int fq) const {
#pragma unroll
        for (int ai = 0; ai < 2; ++ai)
#pragma unroll
            for (int m = 0; m < 4; ++m) {
                if (u.half >= 0 && u.half != ai) continue;
                const int T = u.pm * 256 + ai * 128 + wr * 64 + m * 16 + fr;
#pragma unroll
                for (int bj = 0; bj < 2; ++bj) {
                    const int c = u.pn * 256 + bj * 128 + wc * 32 + fq * 8;
                    const u32x4 y = *(const u32x4*)(YG + (size_t)T * 512 + c);
                    f32x4 v0 = acc[ai][bj][m][0], v1 = acc[ai][bj][m][1];
                    v0[0] = bf2f(y.x & 0xffffu) * sigmoid_f(v0[0]); v0[1] = bf2f(y.x >> 16) * sigmoid_f(v0[1]);
                    v0[2] = bf2f(y.y & 0xffffu) * sigmoid_f(v0[2]); v0[3] = bf2f(y.y >> 16) * sigmoid_f(v0[3]);
                    v1[0] = bf2f(y.z & 0xffffu) * sigmoid_f(v1[0]); v1[1] = bf2f(y.z >> 16) * sigmoid_f(v1[1]);
                    v1[2] = bf2f(y.w & 0xffffu) * sigmoid_f(v1[2]); v1[3] = bf2f(y.w >> 16) * sigmoid_f(v1[3]);
                    *(u32x4*)(MIX + (size_t)T * 1024 + 512 + c) = pack8(v0, v1);
                }
            }
    }
};
__device__ __forceinline__ void unpack8f(const u32x4 r, f32x4& a, f32x4& b) {
    a[0] = bf2f(r.x & 0xffffu); a[1] = bf2f(r.x >> 16); a[2] = bf2f(r.y & 0xffffu); a[3] = bf2f(r.y >> 16);
    b[0] = bf2f(r.z & 0xffffu); b[1] = bf2f(r.z >> 16); b[2] = bf2f(r.w & 0xffffu); b[3] = bf2f(r.w >> 16);
}
struct EpiOut {
    static constexpr bool PERM = true;
    const float* x; const float* ctx; bf16_t* X1; const float* mod; int layer1;
    __device__ __forceinline__ void operator()(const f32x4 (&acc)[2][2][4][2], const Unit& u, int wr, int wc, int fr, int fq) const {
#pragma unroll
        for (int ai = 0; ai < 2; ++ai)
#pragma unroll
            for (int m = 0; m < 4; ++m) {
                if (u.half >= 0 && u.half != ai) continue;
                const int T = u.pm * 256 + ai * 128 + wr * 64 + m * 16 + fr;
                const float* src = T < NCTX ? ctx + (size_t)T * 1024 : x + (size_t)(T - NCTX) * 1024;
                const float* gate = mod + tok_b5(T) * 6144 + 2 * 1024;
                bf16_t* dst = X1 + (size_t)T * 1024;
#pragma unroll
                for (int bj = 0; bj < 2; ++bj) {
                    const int c = u.pn * 256 + bj * 128 + wc * 32 + fq * 8;
                    f32x4 x0, x1;
                    if (layer1) unpack8f(*(const u32x4*)(dst + c), x0, x1); else { x0 = *(const f32x4*)(src + c); x1 = *(const f32x4*)(src + c + 4); }
                    const f32x4 g0 = *(const f32x4*)(gate + c), g1 = *(const f32x4*)(gate + c + 4);
                    *(u32x4*)(dst + c) = pack8(x0 + g0 * acc[ai][bj][m][0], x1 + g1 * acc[ai][bj][m][1]);
                }
            }
    }
};
struct EpiM1 {
    static constexpr bool PERM = true;
    bf16_t* ACT;
    __device__ __forceinline__ void operator()(const f32x4 (&acc)[2][2][4][2], const Unit& u, int wr, int wc, int fr, int fq) const {
#pragma unroll
        for (int ai = 0; ai < 2; ++ai)
#pragma unroll
            for (int m = 0; m < 4; ++m) {
                if (u.half >= 0 && u.half != ai) continue;
                const int row = u.pm * 256 + ai * 128 + wr * 64 + m * 16 + fr;
                f32x4 v0, v1;
#pragma unroll
                for (int j = 0; j < 4; ++j) { v0[j] = silu_f(acc[ai][0][m][0][j]) * acc[ai][1][m][0][j]; v1[j] = silu_f(acc[ai][0][m][1][j]) * acc[ai][1][m][1][j]; }
                *(u32x4*)(ACT + (size_t)row * 512 + u.pn * 128 + wc * 32 + fq * 8) = pack8(v0, v1);
            }
    }
};
struct EpiM2 {
    static constexpr bool PERM = true;
    bf16_t* YB;
    __device__ __forceinline__ void operator()(const f32x4 (&acc)[2][2][4][2], const Unit& u, int wr, int wc, int fr, int fq) const {
#pragma unroll
        for (int ai = 0; ai < 2; ++ai)
#pragma unroll
            for (int m = 0; m < 4; ++m) {
                if (u.half >= 0 && u.half != ai) continue;
                const int row = u.pm * 256 + ai * 128 + wr * 64 + m * 16 + fr;
#pragma unroll
                for (int bj = 0; bj < 2; ++bj)
                    *(u32x4*)(YB + (size_t)row * 1024 + u.pn * 256 + bj * 128 + wc * 32 + fq * 8) = pack8(acc[ai][bj][m][0], acc[ai][bj][m][1]);
            }
    }
};
struct EpiIn1 {
    static constexpr bool PERM = true;
    bf16_t *Q1, *K1, *VT1, *ZHT; const float* qn; const float* kn; LAS float* xch;
    __device__ __forceinline__ void operator()(const f32x4 (&acc)[2][2][4][2], const Unit& u, int wr, int wc, int fr, int fq) const {
        if (u.pn < 4) {
            const int wv = wr * 4 + wc;
#pragma unroll
            for (int ai = 0; ai < 2; ++ai)
#pragma unroll
                for (int bj = 0; bj < 2; ++bj)
#pragma unroll
                    for (int m = 0; m < 4; ++m) {
                        const f32x4 v0 = acc[ai][bj][m][0], v1 = acc[ai][bj][m][1];
                        float ss = (v0[0] * v0[0] + v0[1] * v0[1]) + (v0[2] * v0[2] + v0[3] * v0[3]) + (v1[0] * v1[0] + v1[1] * v1[1]) + (v1[2] * v1[2] + v1[3] * v1[3]);
                        ss += __shfl_xor(ss, 16); ss += __shfl_xor(ss, 32);
                        if (fq == 0) xch[(wv * 16 + (ai * 2 + bj) * 4 + m) * 16 + fr] = ss;
                    }
            asm volatile("s_waitcnt lgkmcnt(0)" ::: "memory"); __builtin_amdgcn_s_barrier(); asm volatile("" ::: "memory");
            const bool isq = u.pn < 2;
            const float* nw = (isq ? qn : kn) + (wc & 1) * 32 + fq * 8;
            const f32x4 n0 = *(const f32x4*)nw, n1 = *(const f32x4*)(nw + 4);
            const float qs = isq ? 0.125f : 1.f;
#pragma unroll
            for (int ai = 0; ai < 2; ++ai)
#pragma unroll
                for (int m = 0; m < 4; ++m) {
                    if (u.half >= 0 && u.half != ai) continue;
                    const int T = u.pm * 256 + ai * 128 + wr * 64 + m * 16 + fr;
#pragma unroll
                    for (int bj = 0; bj < 2; ++bj) {
                        const int q = (ai * 2 + bj) * 4 + m, c = u.pn * 256 + bj * 128 + wc * 32 + fq * 8;
                        const float ss = xch[(wv * 16 + q) * 16 + fr] + xch[((wv ^ 1) * 16 + q) * 16 + fr];
                        const float rinv = rsqrtf(ss * (1.f / 64.f) + EPS) * qs;
                        const f32x4 v0 = acc[ai][bj][m][0] * rinv * n0, v1 = acc[ai][bj][m][1] * rinv * n1;
                        if (isq) *(u32x4*)(Q1 + (size_t)(T - NCTX) * 512 + c) = pack8(v0, v1);
                        else *(u32x4*)(K1 + (size_t)T * 512 + (c - 512)) = pack8(v0, v1);
                    }
                }
            asm volatile("s_waitcnt lgkmcnt(0)" ::: "memory"); __builtin_amdgcn_s_barrier(); asm volatile("" ::: "memory");
            return;
        }
        const int Tq = u.pm * 256 + wc * 32 + fq * 8, ch0 = u.pn * 256 + wr * 64 + fr;
        size_t pitch; bf16_t* base;
        if (u.pn < 6) {
            if (Tq >= NCTX) { const int Tl = Tq - NCTX, b = Tl >> 13, pos = Tl & 8191; pitch = 8192; base = VT1 + ((size_t)(b * 512 + ch0 - 1024)) * 8192 + pos; }
            else { const int b = Tq >> 8, pos = Tq & 255; pitch = 256; base = VT1 + (size_t)NB * 8 * 64 * 8192 + ((size_t)(b * 512 + ch0 - 1024)) * 256 + pos; }
        } else { pitch = NLAT; base = ZHT + (size_t)(ch0 - 1536) * NLAT + (Tq - NCTX); }
#pragma unroll
        for (int ai = 0; ai < 2; ++ai)
#pragma unroll
            for (int m = 0; m < 4; ++m) {
                if (u.half >= 0 && u.half != ai) continue;
#pragma unroll
                for (int bj = 0; bj < 2; ++bj) *(u32x4*)(base + (size_t)(ai * 128 + m * 16) * pitch + bj * 128) = pack8(acc[ai][bj][m][0], acc[ai][bj][m][1]);
            }
    }
};

struct SchedDense {
    g8::DenseOrder ord; const char* A; const char* Bt; size_t atile, btile; int pm_off;
    int swap_lo = 0, swap_hi = 0;
    __device__ __forceinline__ bool next(int i, Unit& u) const {
        int L, pm, pn; if (!g8::tail_split(i, ord.G, ord.c, ord.nwg, L, u.half) || !ord.mapL(L, pm, pn)) return false;
        u.pm = pm + pm_off; u.pn = pn; u.aux = 0; u.rows = nullptr;
        const bool sw = pn >= swap_lo && pn < swap_hi;
        u.a = sw ? Bt + (size_t)pn * btile : A + (size_t)pm * atile; u.b = sw ? A + (size_t)pm * atile : Bt + (size_t)pn * btile; return true;
    }
};
struct SchedIn1 {
    g8::DenseOrder ord; const char* A; const char* Bt; int G, c;
    __device__ __forceinline__ bool next(int i, Unit& u) const {
        int L, pm, pn; if (!g8::tail_split(i, G, c, ord.nwg + 16, L, u.half)) return false;
        if (L < ord.nwg) { ord.mapL(L, pm, pn); pm += 4; }
        else { const int Lc = L - ord.nwg; pm = Lc >> 2; pn = 2 + (Lc & 3); }
        u.pm = pm; u.pn = pn; u.aux = 0; u.rows = nullptr;
        const char* ta = A + (size_t)pm * 256 * 1024 * 2; const char* tb = Bt + (size_t)pn * 256 * 1024 * 2;
        u.a = pn >= 4 ? tb : ta; u.b = pn >= 4 ? ta : tb; return true;
    }
};
struct SchedS5 {
    const char* AS5; const char* Wt; int nN, K, G, c;
    __device__ __forceinline__ bool next(int i, Unit& u) const {
        int L; if (!g8::tail_split(i, G, c, 32 * 5 * nN, L, u.half)) return false;
        const int g = L / (5 * nN), rem = L % (5 * nN), pm = rem / nN, pn = rem % nN;
        u.pm = pm; u.pn = pn; u.aux = g; u.rows = nullptr;
        u.a = AS5 + ((size_t)g * S5ROWS + pm * 256) * S5K * 2;
        u.b = Wt + ((size_t)g * nN * 256 + pn * 256) * K * 2; return true;
    }
};
struct SchedMoe {
    const int* tiles; const int* tokbuf; const char* A; const char* W; size_t wexp, wtile, atile; int G, c, gather;
    __device__ __forceinline__ bool next(int i, Unit& u) const {
        const int nt = tiles[0]; int L; if (!g8::tail_split(i, G, c, nt * 4, L, u.half)) return false;
        const int tile = L >> 2, pn = L & 3, e = tiles[1 + tile];
        u.pm = tile; u.pn = pn; u.aux = e; u.rows = tokbuf + tile * 256;
        u.a = gather ? A : A + (size_t)tile * atile; u.b = W + (size_t)e * wexp + (size_t)pn * wtile; return true;
    }
};
#define XB_TMO      128
#define XB_XCNT(j)  (256  + 64 * (j))
#define XB_XSUB(j)  (1280 + 64 * (j))
#define XB_XGEN(j)  (2304 + 64 * (j))
#define XB_TOP      3328
#define XB_TOPGEN   3392
#define XCD_BAR_WORDS 3456
#define XB_SPIN_CAP (1u << 24)
__device__ __forceinline__ unsigned xb_ld(unsigned* p)              { return __hip_atomic_load(p, __ATOMIC_RELAXED, __HIP_MEMORY_SCOPE_AGENT); }
__device__ __forceinline__ unsigned xb_add(unsigned* p, unsigned v) { return __hip_atomic_fetch_add(p, v, __ATOMIC_RELAXED, __HIP_MEMORY_SCOPE_AGENT); }
__device__ __forceinline__ unsigned xb_xcc_id() { return (unsigned)__builtin_amdgcn_s_getreg((3 << 11) | 20) & 0xFu; }
#define XB_SPIN(cond, bar) do { unsigned _sp = 0; while (cond) { __builtin_amdgcn_s_sleep(1); \
    if ((++_sp & 255u) == 0u) { if (xb_ld(&(bar)[XB_TMO])) break; if (_sp > XB_SPIN_CAP) { atomicAdd(&(bar)[XB_TMO], 1u); break; } } } } while (0)
struct XcdBarrier { unsigned* bar; unsigned x; volatile LAS unsigned* st; };
__device__ __forceinline__ XcdBarrier xcd_barrier_post(unsigned* bar, volatile LAS unsigned* st) {
    XcdBarrier b; b.bar = bar; b.x = xb_xcc_id(); b.st = st;
    if (threadIdx.x == 0) (void)xb_add(&bar[XB_XCNT(b.x)], 1u);
    return b;
}
__device__ __forceinline__ void xcd_barrier_complete(unsigned* bar, unsigned x, unsigned& nloc, unsigned& nx) {
    const unsigned G = gridDim.x * gridDim.y * gridDim.z;
    unsigned sum, cnt, mine, sp = 0u;
    for (;;) {
        sum = 0u; cnt = 0u; mine = 0u;
#pragma unroll
        for (unsigned j = 0; j < 16; ++j) { const unsigned c = xb_ld(&bar[XB_XCNT(j)]); sum += c; cnt += (c > 0u) ? 1u : 0u; mine = (j == x) ? c : mine; }
        if (sum == G) break;
        __builtin_amdgcn_s_sleep(1);
        if ((++sp & 255u) == 0u) { if (xb_ld(&bar[XB_TMO])) break; if (sp > XB_SPIN_CAP) { atomicAdd(&bar[XB_TMO], 1u); break; } }
    }
    nloc = mine > 0u ? mine : 1u; nx = cnt > 0u ? cnt : 1u;
}
__device__ __forceinline__ void xcd_barrier(const XcdBarrier& b) {
    asm volatile("s_waitcnt vmcnt(0)" ::: "memory");
    __syncthreads();
    if (threadIdx.x == 0) {
        unsigned* bar = b.bar;
        __builtin_amdgcn_s_waitcnt(0);
        unsigned nloc = b.st[0], nx = b.st[1];
        if (nloc == 0u) { xcd_barrier_complete(bar, b.x, nloc, nx); b.st[0] = nloc; b.st[1] = nx; }
        const unsigned old = xb_add(&bar[XB_XSUB(b.x)], 1u);
        const unsigned gen = old / nloc;
        if (old + 1u == (gen + 1u) * nloc) {
            __builtin_amdgcn_fence(__ATOMIC_RELEASE, "agent");
            asm volatile("s_waitcnt vmcnt(0)" ::: "memory");
            const unsigned og = xb_add(&bar[XB_TOP], 1u);
            const unsigned tg = og / nx;
            if (og + 1u == (tg + 1u) * nx) xb_add(&bar[XB_TOPGEN], 1u);
            else XB_SPIN(xb_ld(&bar[XB_TOPGEN]) == tg, bar);
            __builtin_amdgcn_fence(__ATOMIC_ACQUIRE, "agent");
            xb_add(&bar[XB_XGEN(b.x)], 1u);
            asm volatile("s_waitcnt vmcnt(0)" ::: "memory");
        } else {
            XB_SPIN(xb_ld(&bar[XB_XGEN(b.x)]) == gen, bar);
            __builtin_amdgcn_fence(__ATOMIC_ACQUIRE, "agent");
            asm volatile("s_waitcnt vmcnt(0)" ::: "memory");
        }
    }
    __syncthreads();
}

constexpr int LDS_BYTES = 163840;
constexpr int LDSCTL_OFF = 163840 - 64;
struct Args { const float* in[43]; float* out; unsigned char* ws; int ph_lo, ph_hi, sub, li; };
enum { I_X = 0, I_C, I_CTX, I_CCTX, I_ADAW, I_ADAB, I_WG, I_BG, I_WE, I_BE, I_W1, I_W3, I_W2, I_EVIN, I_EVOUT, I_WA2, I_BA, I_GNORM,
       I_LAMRE, I_LAMIM, I_LOGDT, I_BRE, I_BIM, I_CRE, I_CIM, I_S5D, I_WGLU, I_ODIN, I_ODOUT, I_QN, I_KN, I_RPB, I_CONVW, I_CONVB,
       I_FW1, I_FB1, I_FW2, I_FB2, I_FW3, I_FB3, I_FREQ, I_FW4, I_HBIAS };

struct Frame {
    LAS unsigned char* lds;
    const Args* a;
    unsigned char* ws;
    int wave, G, bid;
};
#define FTID ((int)threadIdx.x)
#define FLANE ((int)(threadIdx.x & 63))
#define WSP(T, off) ((T*)(F.ws + (off)))

__device__ __forceinline__ void transpose_item(const float* W, int ldw, int col0, int K, bf16_t* WT, int row0, int kb, LAS float* scr, int lane, bool zero) {
    const int k0 = 64 * kb;
    if (!zero) {
        float wv[32];
#pragma unroll
        for (int i = 0; i < 32; ++i) { const int kk = 2 * i + (lane >> 5); wv[i] = W[(size_t)(k0 + kk) * ldw + col0 + (lane & 31)]; }
#pragma unroll
        for (int i = 0; i < 32; ++i) { const int kk = 2 * i + (lane >> 5); scr[kk * 33 + (lane & 31)] = wv[i]; }
    }
    LDS_WAIT(); asm volatile("" ::: "memory");
    const int c = lane & 7;
#pragma unroll
    for (int j = 0; j < 4; ++j) { const int n = (lane >> 3) + 8 * j; const LAS float* s = scr + (8 * c) * 33 + n;
        u32x4 o;
        if (zero) { o = (u32x4){0u, 0u, 0u, 0u}; }
        else { o.x = pk2(s[0 * 33], s[1 * 33]); o.y = pk2(s[2 * 33], s[3 * 33]); o.z = pk2(s[4 * 33], s[5 * 33]); o.w = pk2(s[6 * 33], s[7 * 33]); }
        *(u32x4*)(WT + (size_t)(row0 + n) * K + k0 + 8 * c) = o; }
    LDS_WAIT(); asm volatile("" ::: "memory");
}
__device__ __forceinline__ void moe_conv_item(const Frame& F, int layer, int it, LAS float* scr) {
    const int e = it / 768, r = it % 768;
    if (r < 512) {
        const int kb = r >> 5, nb = r & 31, drow = nb * 32;
        const int pn = drow >> 8, within = drow & 255, isw3 = within >> 7, col = pn * 128 + (within & 127);
        const float* W = F.a->in[isw3 ? I_W3 : I_W1] + ((size_t)layer * NEXP + e) * 1024 * 512;
        transpose_item(W, 512, col, 1024, WSP(bf16_t, layer ? W_M13B : W_M13) + (size_t)e * 1024 * 1024, drow, kb, scr, FLANE, false);
    } else {
        const int rr = r - 512, kb = rr >> 5, nb = rr & 31;
        const float* W = F.a->in[I_W2] + ((size_t)layer * NEXP + e) * 512 * 1024;
        transpose_item(W, 1024, nb * 32, 512, WSP(bf16_t, W_M2) + (size_t)e * 1024 * 512, nb * 32, kb, scr, FLANE, false);
    }
}
__device__ __forceinline__ void small_conv_item(const Frame& F, int it, LAS float* scr) {
    if (it < 1024) {
        const int kb = it >> 6, nb = it & 63, drow = nb * 32;
        const int col = drow < 1536 ? drow : drow + 32;
        transpose_item(F.a->in[I_EVIN], 2080, col, 1024, WSP(bf16_t, W_IN0), drow, kb, scr, FLANE, false); return; }
    it -= 1024;
    if (it < 512) { transpose_item(F.a->in[I_EVOUT], 1024, (it & 31) * 32, 1024, WSP(bf16_t, W_OUT0), (it & 31) * 32, it >> 5, scr, FLANE, false); return; }
    it -= 512;
    if (it < 128) { transpose_item(F.a->in[I_WGLU], 512, (it & 15) * 32, 512, WSP(bf16_t, W_GLU), (it & 15) * 32, it >> 4, scr, FLANE, false); return; }
    it -= 128;
    if (it < 1536) { transpose_item(F.a->in[I_ODIN], 3072, (it % 96) * 32, 1024, WSP(bf16_t, W_IN1), (it % 96) * 32, it / 96, scr, FLANE, false); return; }
    it -= 1536;
    transpose_item(F.a->in[I_ODOUT], 1024, (it & 31) * 32, 1024, WSP(bf16_t, W_OUT1), (it & 31) * 32, it >> 5, scr, FLANE, false);
}
constexpr int SMALL_ITEMS = 1024 + 512 + 128 + 1536 + 512;
__device__ __forceinline__ void fold_la_weights(const Frame& F) {
    const float* win = F.a->in[I_EVIN]; const float* wa2 = F.a->in[I_WA2]; bf16_t* WT = WSP(bf16_t, W_IN0) + (size_t)2048 * 1024;
    for (int i = F.bid * 512 + FTID; i < 512 * 1024; i += F.G * 512) {
        const int k = i & 1023, n = i >> 10, d = n >> 8, c = n & 255;
        const float* a = win + (size_t)k * 2080 + 1536 + 16 * d; float s = 0.f;
#pragma unroll
        for (int r = 0; r < 16; ++r) s += a[r] * wa2[(d * 16 + r) * 256 + c];
        WT[(size_t)n * 1024 + k] = (bf16_t)f2bf(s);
    }
}
constexpr int MOE_ITEMS = 32 * 768;

__device__ __forceinline__ void moe_conv_desc(const Frame& F, int layer, int it, const float*& src, int& ldw, bf16_t*& dst, int& K) {
    const int e = it / 768, r = it % 768;
    if (r < 512) {
        const int kb = r >> 5, nb = r & 31, drow = nb * 32;
        const int pn = drow >> 8, within = drow & 255, isw3 = within >> 7, col = pn * 128 + (within & 127);
        src = F.a->in[isw3 ? I_W3 : I_W1] + ((size_t)layer * NEXP + e) * 1024 * 512 + (size_t)(64 * kb) * 512 + col; ldw = 512;
        dst = WSP(bf16_t, layer ? W_M13B : W_M13) + (size_t)e * 1024 * 1024 + (size_t)drow * 1024 + 64 * kb; K = 1024;
    } else {
        const int rr = r - 512, kb = rr >> 5, nb = rr & 31;
        src = F.a->in[I_W2] + ((size_t)layer * NEXP + e) * 512 * 1024 + (size_t)(64 * kb) * 1024 + nb * 32; ldw = 1024;
        dst = WSP(bf16_t, W_M2) + (size_t)e * 1024 * 512 + (size_t)(nb * 32) * 512 + 64 * kb; K = 512;
    }
}
constexpr int RIDE_L1_FROM = 3072 + 5120;
__device__ __forceinline__ int moe_conv_map(int kind, int i) {
    if (kind == 3) { if (i < 32 * 256) kind = 2; else { kind = 1; i = RIDE_L1_FROM + (i - 32 * 256); } }
    return kind == 0 ? i : (kind == 1 ? (i >> 9) * 768 + (i & 511) : (i >> 8) * 768 + 512 + (i & 255)); }
__device__ __forceinline__ int moe_conv_count(int kind) { return kind == 0 ? MOE_ITEMS : (kind == 1 ? 32 * 512 : (kind == 2 ? 32 * 256 : 32 * 256 + 32 * 512 - RIDE_L1_FROM)); }
__device__ __forceinline__ void idle_conv(const Frame& F, int first_idle, int layer, int lo, int hi) {
    const int nb = F.G - first_idle;
    __syncthreads();
    LAS float* scr = (LAS float*)(F.lds + F.wave * 16384);
    if (nb >= 64) { if (F.bid >= first_idle) for (int it = lo + (F.bid - first_idle) * 8 + F.wave; it < hi; it += nb * 8) moe_conv_item(F, layer, moe_conv_map(1, it), scr); }
    else for (int it = lo + F.bid * 8 + F.wave; it < hi; it += F.G * 8) moe_conv_item(F, layer, moe_conv_map(1, it), scr);
    __syncthreads();
}
__device__ __forceinline__ void tail_conv(const Frame& F, int nwg, int layer, int lo, int hi) {
    const int tl = nwg % F.G, nx = 2 * tl <= F.G ? 2 * tl : tl;
    idle_conv(F, nx, layer, lo, hi);
}
constexpr int TC_L0_A = 4224, TC_L0_B = TC_L0_A + 3840, TC_L0_C = TC_L0_B + 1920, TC_L0_D = TC_L0_C + 1920;
constexpr int TC_L1_A = 1536, TC_L1_B = 3072, TC_L1_C = TC_L1_B + 5120;
static_assert(TC_L1_C == RIDE_L1_FROM, "router-1 ride range");
struct ConvSt { int cit, n, kind, half, ldw, K; const float* src; bf16_t* dst; };
struct ConvSet { bf16_t* dst; int K, half, pend; };
__device__ __forceinline__ void conv_retire(ConvSet& q, const float (&wv)[16], LAS float* scr, int lane) {
    if (!q.pend) return;
#pragma unroll
    for (int i = 0; i < 16; ++i) scr[(2 * i + (lane >> 5)) * 33 + (lane & 31)] = wv[i];
    LDS_WAIT(); asm volatile("" ::: "memory");
#pragma unroll
    for (int j = 0; j < 2; ++j) { const int p = lane + 64 * j, n = p >> 2, c = p & 3; const LAS float* s = scr + (8 * c) * 33 + n;
        u32x4 o; o.x = pk2(s[0 * 33], s[1 * 33]); o.y = pk2(s[2 * 33], s[3 * 33]); o.z = pk2(s[4 * 33], s[5 * 33]); o.w = pk2(s[6 * 33], s[7 * 33]);
        *(u32x4*)(q.dst + (size_t)n * q.K + 32 * q.half + 8 * c) = o; }
    LDS_WAIT(); asm volatile("" ::: "memory");
    q.pend = 0;
}
__device__ __forceinline__ void conv_issue(const Frame& F, int layer, ConvSt& s, ConvSet& q, float (&wv)[16], int lane, int cstride) {
    if (s.cit >= s.n) return;
    if (s.half == 0) moe_conv_desc(F, layer, moe_conv_map(s.kind, s.cit), s.src, s.ldw, s.dst, s.K);
#pragma unroll
    for (int i = 0; i < 16; ++i) wv[i] = s.src[(size_t)(32 * s.half + 2 * i + (lane >> 5)) * s.ldw + (lane & 31)];
    q.dst = s.dst; q.K = s.K; q.half = s.half; q.pend = 1;
    if (s.half == 1) s.cit += cstride;
    s.half ^= 1;
}
#define CONV_SLOT(q, wv) do { conv_retire(q, wv, cscr, lane); conv_issue(F, layer, cs, q, wv, lane, cstride); } while (0)

__device__ __forceinline__ void mod_item(const Frame& F, int it, const LAS float* sc  , LAS float* part  ) {
    const int layer = it / 96, cb = it % 96, col = cb * 64 + FLANE, w = F.wave;
    const float* W = F.a->in[I_ADAW] + (size_t)layer * 1024 * 6144 + (size_t)(128 * w) * 6144 + col;
    float acc[5] = {0.f, 0.f, 0.f, 0.f, 0.f};
#pragma unroll 8
    for (int k = 0; k < 128; ++k) { const float wv = W[(size_t)k * 6144];
#pragma unroll
        for (int v = 0; v < 5; ++v) acc[v] += sc[v * 1024 + 128 * w + k] * wv; }
    __syncthreads();
#pragma unroll
    for (int v = 0; v < 5; ++v) part[(w * 5 + v) * 64 + FLANE] = acc[v];
    __syncthreads();
    if (FTID < 320) { const int v = FTID >> 6, l = FTID & 63; float s = 0.f;
#pragma unroll
        for (int ww = 0; ww < 8; ++ww) s += part[(ww * 5 + v) * 64 + l];
        WSP(float, M_MOD)[(layer * 5 + v) * 6144 + cb * 64 + l] = s + F.a->in[I_ADAB][layer * 6144 + cb * 64 + l]; }
}

__device__ __forceinline__ void hy_hidden_items(const Frame& F, int t_first, int t_step) {
    const float* fw1 = F.a->in[I_FW1]; const float* fw2 = F.a->in[I_FW2]; const float* fw3 = F.a->in[I_FW3];
    const int j = FLANE; const float fr = F.a->in[I_FREQ][j];
    float w2[64], w3[64];
#pragma unroll
    for (int i = 0; i < 64; ++i) { w2[i] = fw2[i * 64 + j]; w3[i] = fw3[i * 64 + j]; }
    const float b1 = F.a->in[I_FB1][j], b2 = F.a->in[I_FB2][j], b3 = F.a->in[I_FB3][j];
#pragma unroll 1
    for (int t = t_first; t < 8192; t += t_step) {
        float feat = 0.f;
        {
            const float w = 6.283185307179586f * (float)t / 8192.f;
            if (j == 0) feat = (float)t / 8191.f;
            else if (j < 33) { const int k = (j - 1) & 15; const float f = 1e-4f + (float)k * ((15.f - 1e-4f) / 15.f); float s, c; sincosf(f * w, &s, &c); feat = (j < 17) ? c : -s; }
        }
        float a1 = b1;
#pragma unroll
        for (int i = 0; i < 33; ++i) a1 += __builtin_bit_cast(float, __builtin_amdgcn_readlane(__builtin_bit_cast(int, feat), i)) * fw1[i * 64 + j];
        const float h1 = sinf(fr * a1);
        float a2 = b2;
#pragma unroll
        for (int i = 0; i < 64; ++i) a2 += __builtin_bit_cast(float, __builtin_amdgcn_readlane(__builtin_bit_cast(int, h1), i)) * w2[i];
        const float h2 = sinf(fr * a2);
        float a3 = b3;
#pragma unroll
        for (int i = 0; i < 64; ++i) a3 += __builtin_bit_cast(float, __builtin_amdgcn_readlane(__builtin_bit_cast(int, h2), i)) * w3[i];
        WSP(float, M_H3)[t * 64 + j] = sinf(fr * a3);
    }
}
__device__ __forceinline__ void s5_tables(const Frame& F, int g, LAS f32x2* Cc, LAS f32x2* Bb, LAS f32x2* AP) {
    const int tid = FTID;
    const float* lam_re = F.a->in[I_LAMRE]; const float* lam_im = F.a->in[I_LAMIM]; const float* log_dt = F.a->in[I_LOGDT];
    const float* b_re = F.a->in[I_BRE]; const float* b_im = F.a->in[I_BIM]; const float* c_re = F.a->in[I_CRE]; const float* c_im = F.a->in[I_CIM];
    __syncthreads();
    for (int i = tid; i < 2 * 64 * 33; i += 512) {
        const int e = i % 33, dp = i / 33, d = dp >> 6, p = dp & 63, gp = (d * 32 + g) * 64 + p;
        const float dt = __expf(log_dt[d * 32 + g]);
        const float mag = expf(lam_re[gp] * dt * (float)e); float s, c; sincosf(lam_im[gp] * dt * (float)e, &s, &c); AP[i] = (f32x2){mag * c, mag * s};
    }
    for (int i = tid; i < 2 * 64 * 16; i += 512) {
        const int h = i & 15, dp = i >> 4, d = dp >> 6, p = dp & 63, gp = (d * 32 + g) * 64 + p;
        const float lr = lam_re[gp], li = lam_im[gp], dt = __expf(log_dt[d * 32 + g]);
        const float mag = expf(lr * dt); float s, c; sincosf(li * dt, &s, &c);
        const float ar = mag * c, ai = mag * s, den = lr * lr + li * li, nr = ar - 1.f;
        const float cor = (nr * lr + ai * li) / den, coi = (ai * lr - nr * li) / den;
        const float br = b_re[(size_t)gp * 16 + h], bi = b_im[(size_t)gp * 16 + h]; Bb[i] = (f32x2){cor * br - coi * bi, cor * bi + coi * br};
    }
    for (int i = tid; i < 2 * 16 * 64; i += 512) { const int d = i >> 10, hp = (i >> 6) & 15, p = i & 63; const size_t gi = ((size_t)(d * 32 + g) * 16 + hp) * 64 + p; Cc[i] = (f32x2){c_re[gi], c_im[gi]}; }
    __syncthreads();
}
__device__ __forceinline__ void s5_kern_part(const Frame& F, int g, int part) {
    LAS f32x2* Cc = (LAS f32x2*)F.lds; LAS f32x2* Bb = Cc + 2 * 16 * 64; LAS f32x2* AP = Bb + 2 * 64 * 16;
    s5_tables(F, g, Cc, Bb, AP);
    const int tid = FTID, d = tid >> 8, hp = (tid >> 4) & 15, h = tid & 15;
    float* KG = WSP(float, M_KERN) + (size_t)g * 2 * 32 * 256;
#pragma unroll 1
    for (int tau = 4 * part; tau < 4 * part + 4; ++tau) {
        float acc = 0.f;
#pragma unroll 4
        for (int p = 0; p < 64; ++p) {
            const f32x2 c = Cc[(d * 16 + hp) * 64 + p], a = AP[(d * 64 + p) * 33 + tau], b = Bb[(d * 64 + p) * 16 + h];
            const float cr = c.x * a.x - c.y * a.y, ci = c.x * a.y + c.y * a.x;
            acc += cr * b.x - ci * b.y;
        }
        KG[((d * 32 + tau) * 16 + hp) * 16 + h] = acc;
    }
    __syncthreads();
}
__device__ __forceinline__ void s5_fill_part(const Frame& F, int g, int part) {
    LAS f32x2* Cc = (LAS f32x2*)F.lds; LAS f32x2* Bb = Cc + 2 * 16 * 64; LAS f32x2* AP = Bb + 2 * 64 * 16; LAS float* KERN = (LAS float*)(AP + 2 * 64 * 33);
    s5_tables(F, g, Cc, Bb, AP);
    const int tid = FTID;
    { const f32x4* KG = (const f32x4*)(WSP(float, M_KERN) + (size_t)g * 2 * 32 * 256); f32x4 kv[8];
#pragma unroll
      for (int q = 0; q < 8; ++q) kv[q] = KG[tid + 512 * q];
#pragma unroll
      for (int q = 0; q < 8; ++q) ((LAS f32x4*)KERN)[tid + 512 * q] = kv[q]; }
    __syncthreads();
    const float* dsk = F.a->in[I_S5D] + g * 16;
    bf16_t* W3 = WSP(bf16_t, W_S3) + (size_t)g * 512 * S5K;
    bf16_t* W1 = WSP(bf16_t, W_S1) + (size_t)g * 256 * S5KU;
    for (int i = tid; i < 64 * (S5K / 8); i += 512) {
        const int n = 64 * part + i / (S5K / 8), k0 = (i % (S5K / 8)) * 8, t = n >> 4, hp = n & 15;
        float v[8];
        if (k0 < S5KU) {
            const int s = k0 >> 4, h0 = k0 & 15;
#pragma unroll
            for (int e = 0; e < 8; ++e) { float val = 0.f;
                if (s <= t) val += KERN[((0 * 32 + (t - s)) * 16 + hp) * 16 + h0 + e];
                if (s >= t) val += KERN[((1 * 32 + (s - t)) * 16 + hp) * 16 + h0 + e];
                if (s == t && h0 + e == hp) val += dsk[hp];
                v[e] = val; }
        } else {
            const int kk = k0 - S5KU, d = kk >> 7, pt = (kk >> 6) & 1, p0 = kk & 63, ex = d == 0 ? t + 1 : S5TC - t;
#pragma unroll
            for (int e = 0; e < 8; ++e) { const f32x2 c = Cc[(d * 16 + hp) * 64 + p0 + e], a = AP[(d * 64 + p0 + e) * 33 + ex];
                v[e] = pt == 0 ? (c.x * a.x - c.y * a.y) : -(c.x * a.y + c.y * a.x); }
        }
        *(u32x4*)(W3 + (size_t)n * S5K + k0) = (u32x4){pk2(v[0], v[1]), pk2(v[2], v[3]), pk2(v[4], v[5]), pk2(v[6], v[7])};
    }
    for (int i = tid; i < 32 * (S5KU / 8); i += 512) {
        const int n = 32 * part + i / (S5KU / 8), k0 = (i % (S5KU / 8)) * 8, d = n >> 7, pt = (n >> 6) & 1, p = n & 63;
        const int s = k0 >> 4, h0 = k0 & 15, ex = d == 0 ? S5TC - 1 - s : s;
        const f32x2 a = AP[(d * 64 + p) * 33 + ex];
        float v[8];
#pragma unroll
        for (int e = 0; e < 8; ++e) { const f32x2 b = Bb[(d * 64 + p) * 16 + h0 + e]; v[e] = pt == 0 ? (a.x * b.x - a.y * b.y) : (a.x * b.y + a.y * b.x); }
        *(u32x4*)(W1 + (size_t)n * S5KU + k0) = (u32x4){pk2(v[0], v[1]), pk2(v[2], v[3]), pk2(v[4], v[5]), pk2(v[6], v[7])};
    }
    __syncthreads();
}

__device__ __forceinline__ void phase0(const Frame& F) {
    const int gw = F.bid * 8 + F.wave, NGW = F.G * 8;
    for (int u = F.bid; u < 256; u += F.G) s5_kern_part(F, u >> 3, u & 7);
    LAS float* sc = (LAS float*)(F.lds + 8 * 16384);
    __syncthreads();
    for (int i = FTID; i < 5 * 1024; i += 512) { const int v = i >> 10, k = i & 1023; const float x = v < 4 ? F.a->in[I_C][v * 1024 + k] : F.a->in[I_CCTX][k]; sc[i] = silu_f(x); }
    __syncthreads();
    for (int it = F.bid; it < 192; it += F.G) mod_item(F, it, sc, (LAS float*)(F.lds + 8 * 16384 + 5 * 4096));
    for (int i = F.bid * 512 + FTID; i < FFTN; i += F.G * 512) { float s, c; sincospif((float)i * (1.0f / 8192.f), &s, &c); WSP(f32x2, M_TW)[i] = (f32x2){c, -s}; }
    for (int i = F.bid * 512 + FTID; i < 128 * 16; i += F.G * 512) { const int pos = i >> 4, j = i & 15; const float fq = powf(10000.f, -(float)j / 16.f); float s, c; sincosf((float)pos * fq, &s, &c); WSP(f32x2, M_ROPE)[i] = (f32x2){c, s}; }
    hy_hidden_items(F, gw, NGW);
    LAS float* scr = (LAS float*)(F.lds + F.wave * 16384);
    fold_la_weights(F);
    for (int it = gw; it < SMALL_ITEMS; it += NGW) small_conv_item(F, it, scr);
}

__device__ __forceinline__ void norm_mod_row(const float* xrow, const float* shift, const float* scale, bf16_t* orow, int lane) {
    const f32x4* xr = (const f32x4*)xrow + lane;
    f32x4 v[4]; float s = 0.f;
#pragma unroll
    for (int j = 0; j < 4; ++j) { v[j] = xr[64 * j]; s += (v[j].x * v[j].x + v[j].y * v[j].y) + (v[j].z * v[j].z + v[j].w * v[j].w); }
    const float rinv = rsqrtf(wave_sum(s) * (1.f / 1024.f) + EPS);
    unsigned long long* o8 = (unsigned long long*)orow + lane;
#pragma unroll
    for (int j = 0; j < 4; ++j) {
        const f32x4 sh = ((const f32x4*)shift)[lane + 64 * j], sl = ((const f32x4*)scale)[lane + 64 * j];
        const f32x4 h = v[j] * rinv * (sl + 1.f) + sh;
        o8[64 * j] = (unsigned long long)pk2(h.x, h.y) | ((unsigned long long)pk2(h.z, h.w) << 32);
    }
}
__device__ __forceinline__ void phase1_norm0(const Frame& F) {
    for (int u = F.bid; u < 256; u += F.G) s5_fill_part(F, u >> 3, u & 7);
    const int gw = F.bid * 8 + F.wave, NGW = F.G * 8;
    const float* mod = WSP(float, M_MOD);
    const int lane = FLANE;
    for (int T = gw; T < NTOK; T += 2 * NGW) {
        const int T2 = T + NGW; const bool has2 = T2 < NTOK; const int Tb = has2 ? T2 : T;
        const float* xa = T < NCTX ? F.a->in[I_CTX] + (size_t)T * 1024 : F.a->in[I_X] + (size_t)(T - NCTX) * 1024;
        const float* xb = Tb < NCTX ? F.a->in[I_CTX] + (size_t)Tb * 1024 : F.a->in[I_X] + (size_t)(Tb - NCTX) * 1024;
        f32x4 va[4], vb[4]; float sa = 0.f, sb = 0.f;
#pragma unroll
        for (int j = 0; j < 2; ++j) { va[2 * j] = ((const f32x4*)xa)[2 * lane + 128 * j]; va[2 * j + 1] = ((const f32x4*)xa)[2 * lane + 128 * j + 1]; vb[2 * j] = ((const f32x4*)xb)[2 * lane + 128 * j]; vb[2 * j + 1] = ((const f32x4*)xb)[2 * lane + 128 * j + 1]; }
#pragma unroll
        for (int j = 0; j < 4; ++j) { sa += (va[j].x * va[j].x + va[j].y * va[j].y) + (va[j].z * va[j].z + va[j].w * va[j].w); sb += (vb[j].x * vb[j].x + vb[j].y * vb[j].y) + (vb[j].z * vb[j].z + vb[j].w * vb[j].w); }
        const float ra = rsqrtf(wave_sum(sa) * (1.f / 1024.f) + EPS), rb = rsqrtf(wave_sum(sb) * (1.f / 1024.f) + EPS);
        const f32x4* ma = (const f32x4*)(mod + tok_b5(T) * 6144) + 2 * lane; const f32x4* mb = (const f32x4*)(mod + tok_b5(Tb) * 6144) + 2 * lane;
        u32x4* oa = (u32x4*)(WSP(bf16_t, B_ABUF) + (size_t)T * 1024) + lane;
        u32x4* ob = (u32x4*)(WSP(bf16_t, B_ABUF) + (size_t)Tb * 1024) + lane;
#pragma unroll
        for (int j = 0; j < 2; ++j) {
            oa[64 * j] = pack8(va[2 * j] * ra * (ma[256 + 128 * j] + 1.f) + ma[128 * j], va[2 * j + 1] * ra * (ma[256 + 128 * j + 1] + 1.f) + ma[128 * j + 1]);
            if (has2) ob[64 * j] = pack8(vb[2 * j] * rb * (mb[256 + 128 * j] + 1.f) + mb[128 * j], vb[2 * j + 1] * rb * (mb[256 + 128 * j + 1] + 1.f) + mb[128 * j + 1]);
        }
    }
}
__device__ __forceinline__ void gla_chunk_info(int ch, int d, int& b, int& c, bool& lat, int& slot) {
    lat = ch >= 16;
    if (!lat) { b = ch >> 2; c = ch & 3; slot = d == 0 ? c : 3 - c; }
    else { b = (ch - 16) >> 7; c = (ch - 16) & 127; slot = d == 0 ? 4 + c : 4 + 127 - c; }
}
constexpr int GP = 72;

#define dpp_f(v, ctrl, row_mask, bc) __builtin_bit_cast(float, __builtin_amdgcn_update_dpp(0, __builtin_bit_cast(int, (v)), (ctrl), (row_mask), 0xF, (bc)))
__device__ __forceinline__ float wave_prefix_incl(float v) {
    v += dpp_f(v, 0x111, 0xF, true);
    v += dpp_f(v, 0x112, 0xF, true);
    v += dpp_f(v, 0x114, 0xF, true);
    v += dpp_f(v, 0x118, 0xF, true);
    v += dpp_f(v, 0x142, 0xA, false);
    v += dpp_f(v, 0x143, 0xC, false);
    return v;
}
__device__ __forceinline__ void unpack8(const u32x4 r, float* o) {
    o[0] = bf2f(r.x & 0xffffu); o[1] = bf2f(r.x >> 16); o[2] = bf2f(r.y & 0xffffu); o[3] = bf2f(r.y >> 16);
    o[4] = bf2f(r.z & 0xffffu); o[5] = bf2f(r.z >> 16); o[6] = bf2f(r.w & 0xffffu); o[7] = bf2f(r.w >> 16);
}
__device__ __forceinline__ void gla_c1_unit(const Frame& F, int ch) {
    LAS float* decs = (LAS float*)(F.lds + 8 * 64 * GP * 2) + F.wave * 64;
    LAS bf16_t* ket = (LAS bf16_t*)(F.lds + F.wave * 64 * GP * 2);
    const int h = F.wave >> 1, d = F.wave & 1, lane = FLANE, fr = lane & 15, fq = lane >> 4;
    int b, c; bool lat; int slot; gla_chunk_info(ch, d, b, c, lat, slot);
    {
        const size_t T = (size_t)ch * 64 + lane;
        const u32x4* kp = (const u32x4*)(WSP(bf16_t, B_QK) + T * 512 + 256 + h * 64);
        const u32x4* lp = (const u32x4*)(WSP(bf16_t, B_LA) + T * 512 + d * 256 + h * 64);
        u32x4 kr[8], lr[8];
#pragma unroll
        for (int q = 0; q < 8; ++q) { kr[q] = kp[q]; lr[q] = lp[q]; }
        float kf[64], lf[64];
#pragma unroll
        for (int q = 0; q < 8; ++q) { unpack8(kr[q], kf + 8 * q); unpack8(lr[q], lf + 8 * q); }
        if (lat) {
            const f32x2* rope = WSP(f32x2, M_ROPE);
#pragma unroll
            for (int j = 0; j < 16; ++j) {
                const f32x2 cr = rope[c * 16 + j], cc = rope[lane * 16 + j];
                const float a1 = kf[j], a2 = kf[16 + j], b1 = kf[32 + j], b2 = kf[48 + j];
                kf[j] = a1 * cr.x - a2 * cr.y; kf[16 + j] = a1 * cr.y + a2 * cr.x;
                kf[32 + j] = b1 * cc.x - b2 * cc.y; kf[48 + j] = b1 * cc.y + b2 * cc.x;
            }
        }
        float mytot = 0.f;
#pragma unroll
        for (int i = 0; i < 64; ++i) {
            const float la = lf[i], pre = wave_prefix_incl(la);
            const float total = __builtin_bit_cast(float, __builtin_amdgcn_readlane(__builtin_bit_cast(int, pre), 63));
            const float bcum = d == 0 ? pre : total - pre + la;
            ket[i * GP + lane] = (bf16_t)f2bf(kf[i] * __expf(-bcum));
            mytot = lane == i ? total : mytot;
        }
        const float dec = __expf(mytot);
        decs[lane] = dec;
        WSP(float, B_DEC)[((size_t)((b * 2 + d) * GSEQ + slot) * 4 + h) * 64 + lane] = dec;
    }
    LDS_WAIT(); asm volatile("" ::: "memory");
    const bf16_t* vt = WSP(bf16_t, B_VT) + (size_t)(ch * 4 + h) * 128 * 64;
    bf16_t* upd = WSP(bf16_t, B_UPD) + ((size_t)((b * 2 + d) * GSEQ + slot) * 4 + h) * 128 * 64;
    bf16x8 Af[4][2];
#pragma unroll
    for (int rt = 0; rt < 4; ++rt)
#pragma unroll
        for (int ks = 0; ks < 2; ++ks) Af[rt][ks] = *(const LAS bf16x8*)(ket + (16 * rt + fr) * GP + 32 * ks + 8 * fq);
#pragma unroll
    for (int ct = 0; ct < 8; ++ct) {
        bf16x8 Bf[2];
#pragma unroll
        for (int ks = 0; ks < 2; ++ks) Bf[ks] = *(const bf16x8*)(vt + (size_t)(16 * ct + fr) * 64 + 32 * ks + 8 * fq);
#pragma unroll
        for (int rt = 0; rt < 4; ++rt) {
            f32x4 a4 = (f32x4){0.f, 0.f, 0.f, 0.f};
            a4 = __builtin_amdgcn_mfma_f32_16x16x32_bf16(Af[rt][0], Bf[0], a4, 0, 0, 0);
            a4 = __builtin_amdgcn_mfma_f32_16x16x32_bf16(Af[rt][1], Bf[1], a4, 0, 0, 0);
            const f32x4 dd = *(const LAS f32x4*)(decs + 16 * rt + 4 * fq);
            u32x2 w; w.x = pk2(a4[0] * dd[0], a4[1] * dd[1]); w.y = pk2(a4[2] * dd[2], a4[3] * dd[3]);
            *(u32x2*)(upd + (size_t)(16 * ct + fr) * 64 + 16 * rt + 4 * fq) = w;
        }
    }
    LDS_WAIT(); asm volatile("" ::: "memory");
}

__device__ __forceinline__ void gla_scan(const Frame& F) {
    for (int idx = F.bid * 512 + FTID; idx < 131072; idx += F.G * 512) {
        const int kp = idx & 31, dv = (idx >> 5) & 127, h = (idx >> 12) & 3, bd = idx >> 14;
        unsigned* u = WSP(unsigned, B_UPD) + ((size_t)(bd * GSEQ * 4 + h) * 128 + dv) * 32 + kp;
        const f32x2* dc = WSP(f32x2, B_DEC) + ((size_t)(bd * GSEQ * 4 + h) * 32 + kp);
        float s0 = 0.f, s1 = 0.f;
        for (int s = 0; s < GSEQ; s += 22) {
            unsigned uu[22]; f32x2 dd[22];
#pragma unroll
            for (int q = 0; q < 22; ++q) { uu[q] = u[(size_t)(s + q) * (4 * 128 * 32)]; dd[q] = dc[(size_t)(s + q) * (4 * 32)]; }
#pragma unroll
            for (int q = 0; q < 22; ++q) {
                u[(size_t)(s + q) * (4 * 128 * 32)] = pk2(s0, s1);
                s0 = dd[q].x * s0 + bf2f(uu[q] & 0xffffu); s1 = dd[q].y * s1 + bf2f(uu[q] >> 16);
            }
        }
    }
}

__device__ __forceinline__ void gla_c3_unit(const Frame& F, int ch, int var) {
    const int h = F.wave >> 1, hf = F.wave & 1, lane = FLANE, fr = lane & 15, fq = lane >> 4;
    LAS bf16_t* qe = (LAS bf16_t*)(F.lds + h * 2 * 64 * GP * 2);
    LAS bf16_t* ke = qe + 64 * GP;
    LAS float* tot = (LAS float*)(F.lds + 4 * 2 * 64 * GP * 2);
    __syncthreads();
    f32x4 acc[4][4];
#pragma unroll
    for (int dt = 0; dt < 4; ++dt)
#pragma unroll
        for (int ti = 0; ti < 4; ++ti) acc[dt][ti] = (f32x4){0.f, 0.f, 0.f, 0.f};
    const bf16_t* vt = WSP(bf16_t, B_VT) + ((size_t)(ch * 4 + h) * 128 + 64 * hf) * 64;
#pragma unroll 1
    for (int d = 0; d < 2; ++d) {
        int b, c; bool lat; int slot; gla_chunk_info(ch, d, b, c, lat, slot);
        const bf16_t* sb = WSP(bf16_t, B_UPD) + (((size_t)((b * 2 + d) * GSEQ + slot) * 4 + h) * 128 + 64 * hf) * 64;
        if (var != 1) {
            const size_t T = (size_t)ch * 64 + lane;
            const u32x4* qp = (const u32x4*)(WSP(bf16_t, B_QK) + T * 512 + h * 64 + 32 * hf);
            const u32x4* kp = (const u32x4*)(WSP(bf16_t, B_QK) + T * 512 + 256 + h * 64 + 32 * hf);
            const u32x4* lp = (const u32x4*)(WSP(bf16_t, B_LA) + T * 512 + d * 256 + h * 64 + 32 * hf);
            u32x4 qr[4], kr[4], lr[4];
#pragma unroll
            for (int q = 0; q < 4; ++q) { qr[q] = qp[q]; kr[q] = kp[q]; lr[q] = lp[q]; }
            float qf[32], kf[32], lf[32];
#pragma unroll
            for (int q = 0; q < 4; ++q) { unpack8(qr[q], qf + 8 * q); unpack8(kr[q], kf + 8 * q); unpack8(lr[q], lf + 8 * q); }
            if (lat) {
                const f32x2* rope = WSP(f32x2, M_ROPE) + (hf == 0 ? c : lane) * 16;
#pragma unroll
                for (int j = 0; j < 16; ++j) {
                    const f32x2 cs = rope[j];
                    const float q1 = qf[j], q2 = qf[16 + j], k1 = kf[j], k2 = kf[16 + j];
                    qf[j] = q1 * cs.x - q2 * cs.y; qf[16 + j] = q1 * cs.y + q2 * cs.x;
                    kf[j] = k1 * cs.x - k2 * cs.y; kf[16 + j] = k1 * cs.y + k2 * cs.x;
                }
            }
            u32x4 qo[4], ko[4];
#pragma unroll
            for (int q = 0; q < 4; ++q) {
                float qe8[8], ke8[8];
#pragma unroll
                for (int e = 0; e < 8; ++e) {
                    const int i = 8 * q + e;
                    const float la = lf[i], pre = wave_prefix_incl(la);
                    const float total = __builtin_bit_cast(float, __builtin_amdgcn_readlane(__builtin_bit_cast(int, pre), 63));
                    const float bcum = d == 0 ? pre : total - pre + la;
                    qe8[e] = qf[i] * __expf(bcum) * 0.125f; ke8[e] = kf[i] * __expf(-bcum);
                }
                qo[q].x = pk2(qe8[0], qe8[1]); qo[q].y = pk2(qe8[2], qe8[3]); qo[q].z = pk2(qe8[4], qe8[5]); qo[q].w = pk2(qe8[6], qe8[7]);
                ko[q].x = pk2(ke8[0], ke8[1]); ko[q].y = pk2(ke8[2], ke8[3]); ko[q].z = pk2(ke8[4], ke8[5]); ko[q].w = pk2(ke8[6], ke8[7]);
            }
            if (d == 1) __syncthreads();
#pragma unroll
            for (int q = 0; q < 4; ++q) { *(LAS u32x4*)(qe + lane * GP + 32 * hf + 8 * q) = qo[q]; *(LAS u32x4*)(ke + lane * GP + 32 * hf + 8 * q) = ko[q]; }
        }
        bf16x8 Av[4][2], As[4][2];
#pragma unroll
        for (int dt = 0; dt < 4; ++dt)
#pragma unroll
            for (int ksp = 0; ksp < 2; ++ksp) {
                const bf16_t* vr = vt + (size_t)(16 * dt + fr) * 64 + 32 * ksp + 4 * fq;
                const u32x2 lo = *(const u32x2*)vr, hi = *(const u32x2*)(vr + 16);
                Av[dt][ksp] = __builtin_bit_cast(bf16x8, (u32x4){lo.x, lo.y, hi.x, hi.y});
                As[dt][ksp] = *(const bf16x8*)(sb + (size_t)(16 * dt + fr) * 64 + 32 * ksp + 8 * fq);
            }
        __syncthreads();
        if (var != 2)
#pragma unroll
        for (int tih = 0; tih < 2; ++tih) {
            bf16x8 Bq[2][2], P[2][2];
#pragma unroll
            for (int t2 = 0; t2 < 2; ++t2)
#pragma unroll
                for (int ks = 0; ks < 2; ++ks) Bq[t2][ks] = *(const LAS bf16x8*)(qe + (16 * (2 * tih + t2) + fr) * GP + 32 * ks + 8 * fq);
#pragma unroll
            for (int t2 = 0; t2 < 2; ++t2) {
                const int ti = 2 * tih + t2, tI = 16 * ti + fr;
#pragma unroll
                for (int ksp = 0; ksp < 2; ++ksp) {
                    f32x4 s2[2];
#pragma unroll
                    for (int x = 0; x < 2; ++x) {
                        const int tj = 2 * ksp + x;
                        const bf16x8 A0 = *(const LAS bf16x8*)(ke + (16 * tj + fr) * GP + 8 * fq), A1 = *(const LAS bf16x8*)(ke + (16 * tj + fr) * GP + 32 + 8 * fq);
                        f32x4 a4 = (f32x4){0.f, 0.f, 0.f, 0.f};
                        a4 = __builtin_amdgcn_mfma_f32_16x16x32_bf16(A0, Bq[t2][0], a4, 0, 0, 0);
                        a4 = __builtin_amdgcn_mfma_f32_16x16x32_bf16(A1, Bq[t2][1], a4, 0, 0, 0);
#pragma unroll
                        for (int i = 0; i < 4; ++i) { const int tJ = 16 * tj + 4 * fq + i; const bool keep = d == 0 ? (tJ <= tI) : (tJ > tI); a4[i] = keep ? a4[i] : 0.f; }
                        s2[x] = a4;
                    }
                    const u32x4 w = pack8(s2[0], s2[1]);
                    P[t2][ksp] = __builtin_bit_cast(bf16x8, w);
                }
            }
#pragma unroll
            for (int dt = 0; dt < 4; ++dt) {
#pragma unroll
                for (int t2 = 0; t2 < 2; ++t2) {
                    f32x4 a4 = acc[dt][2 * tih + t2];
                    a4 = __builtin_amdgcn_mfma_f32_16x16x32_bf16(Av[dt][0], P[t2][0], a4, 0, 0, 0);
                    a4 = __builtin_amdgcn_mfma_f32_16x16x32_bf16(Av[dt][1], P[t2][1], a4, 0, 0, 0);
                    a4 = __builtin_amdgcn_mfma_f32_16x16x32_bf16(As[dt][0], Bq[t2][0], a4, 0, 0, 0);
                    a4 = __builtin_amdgcn_mfma_f32_16x16x32_bf16(As[dt][1], Bq[t2][1], a4, 0, 0, 0);
                    acc[dt][2 * tih + t2] = a4;
                }
            }
            __builtin_amdgcn_sched_barrier(0);
        }
    }
    float ssv[4];
#pragma unroll
    for (int ti = 0; ti < 4; ++ti) {
        float ss = 0.f;
#pragma unroll
        for (int dt = 0; dt < 4; ++dt) { const f32x4 v = acc[dt][ti]; ss += (v[0] * v[0] + v[1] * v[1]) + (v[2] * v[2] + v[3] * v[3]); }
        ss += __shfl_xor(ss, 16); ss += __shfl_xor(ss, 32);
        ssv[ti] = ss;
    }
    __syncthreads();
    if (fq == 0) {
#pragma unroll
        for (int ti = 0; ti < 4; ++ti) tot[(h * 2 + hf) * 64 + 16 * ti + fr] = ssv[ti];
    }
    __syncthreads();
    const float* gn = F.a->in[I_GNORM];
#pragma unroll
    for (int ti = 0; ti < 4; ++ti) {
        const float ss = ssv[ti] + tot[(h * 2 + (hf ^ 1)) * 64 + 16 * ti + fr];
        const float rinv = rsqrtf(ss * (1.f / 128.f) + EPS);
        const int T = ch * 64 + 16 * ti + fr;
        const bf16_t* gp = WSP(bf16_t, B_G) + (size_t)T * 512 + h * 128 + 64 * hf + 4 * fq;
        bf16_t* op = WSP(bf16_t, B_MIX0) + (size_t)T * 1024 + h * 128 + 64 * hf + 4 * fq;
#pragma unroll
        for (int dt = 0; dt < 4; ++dt) {
            const u32x2 gv = *(const u32x2*)(gp + 16 * dt); const f32x4 gw = *(const f32x4*)(gn + 64 * hf + 16 * dt + 4 * fq); const f32x4 v = acc[dt][ti];
            const float o0 = v[0] * rinv * gw[0] * silu_f(bf2f(gv.x & 0xffffu)), o1 = v[1] * rinv * gw[1] * silu_f(bf2f(gv.x >> 16));
            const float o2 = v[2] * rinv * gw[2] * silu_f(bf2f(gv.y & 0xffffu)), o3 = v[3] * rinv * gw[3] * silu_f(bf2f(gv.y >> 16));
            u32x2 w; w.x = pk2(o0, o1); w.y = pk2(o2, o3);
            *(u32x2*)(op + 16 * dt) = w;
        }
    }
}
__device__ __forceinline__ void s5_scan(const Frame& F) {
    const float* lam_re = F.a->in[I_LAMRE]; const float* lam_im = F.a->in[I_LAMIM]; const float* log_dt = F.a->in[I_LOGDT];
    for (int idx = F.bid * 512 + FTID; idx < NB * 2 * 32 * 64; idx += F.G * 512) {
        const int p = idx & 63, g = (idx >> 6) & 31, d = (idx >> 11) & 1, b = idx >> 12;
        const int gp = (d * 32 + g) * 64 + p;
        const float dt = __expf(log_dt[d * 32 + g]);
        const float mag = expf(lam_re[gp] * dt * (float)S5TC); float sn, cs; sincosf(lam_im[gp] * dt * (float)S5TC, &sn, &cs);
        const float ar = mag * cs, ai = mag * sn;
        const float* Z = WSP(float, B_ZS5) + (size_t)g * S5ROWS * 256 + d * 128 + p;
        bf16_t* H = WSP(bf16_t, B_AS5) + (size_t)g * S5ROWS * S5K + S5KU + d * 128 + p;
        float hr = 0.f, hi = 0.f;
        constexpr int NSTEP = (CTX + SEQ) / S5TC;
        for (int s = 0; s < NSTEP; s += 33) {
            float zr[33], zi[33]; int rows[33];
#pragma unroll
            for (int q = 0; q < 33; ++q) {
                const int st = s + q; int row;
                if (st < CTX / S5TC) { const int c = d == 0 ? st : CTX / S5TC - 1 - st; row = 1024 + b * (CTX / S5TC) + c; }
                else { const int c = d == 0 ? st - CTX / S5TC : SEQ / S5TC - 1 - (st - CTX / S5TC); row = b * (SEQ / S5TC) + c; }
                rows[q] = row; zr[q] = Z[(size_t)row * 256]; zi[q] = Z[(size_t)row * 256 + 64];
            }
#pragma unroll
            for (int q = 0; q < 33; ++q) {
                H[(size_t)rows[q] * S5K] = (bf16_t)f2bf(hr); H[(size_t)rows[q] * S5K + 64] = (bf16_t)f2bf(hi);
                const float nr = ar * hr - ai * hi + zr[q], ni = ar * hi + ai * hr + zi[q];
                hr = nr; hi = ni;
            }
        }
    }
}

__device__ __forceinline__ void scans_fused(const Frame& F) {
    const int idx = F.bid * 512 + FTID;
    const int kp = idx & 31, dv = (idx >> 5) & 127, h = (idx >> 12) & 3, bd = idx >> 14;
    unsigned* u = WSP(unsigned, B_UPD) + ((size_t)(bd * GSEQ * 4 + h) * 128 + dv) * 32 + kp;
    const f32x2* dc = WSP(f32x2, B_DEC) + ((size_t)(bd * GSEQ * 4 + h) * 32 + kp);
    float s0 = 0.f, s1 = 0.f;
    const bool has5 = F.wave == 0;
    const int idx5 = F.bid * 64 + FLANE;
    const int p = idx5 & 63, g = (idx5 >> 6) & 31, d = (idx5 >> 11) & 1, b = idx5 >> 12;
    float ar = 0.f, ai = 0.f, hr = 0.f, hi = 0.f;
    const float* Z = WSP(float, B_ZS5) + (size_t)g * S5ROWS * 256 + d * 128 + p;
    bf16_t* H = WSP(bf16_t, B_AS5) + (size_t)g * S5ROWS * S5K + S5KU + d * 128 + p;
    if (has5) {
        const int gp = (d * 32 + g) * 64 + p;
        const float dt = __expf(F.a->in[I_LOGDT][d * 32 + g]);
        const float mag = expf(F.a->in[I_LAMRE][gp] * dt * (float)S5TC); float sn, cs; sincosf(F.a->in[I_LAMIM][gp] * dt * (float)S5TC, &sn, &cs);
        ar = mag * cs; ai = mag * sn;
    }
#pragma unroll 1
    for (int i = 0; i < 8; ++i) {
        unsigned uu[22]; f32x2 dd[22];
        float zr[33], zi[33]; int rows[33];
        if (i < 6) {
            const int s = 22 * i;
#pragma unroll
            for (int q = 0; q < 22; ++q) { uu[q] = u[(size_t)(s + q) * (4 * 128 * 32)]; dd[q] = dc[(size_t)(s + q) * (4 * 32)]; }
        }
        if (has5) {
            const int s = 33 * i;
#pragma unroll
            for (int q = 0; q < 33; ++q) {
                const int st = s + q; int row;
                if (st < CTX / S5TC) { const int c = d == 0 ? st : CTX / S5TC - 1 - st; row = 1024 + b * (CTX / S5TC) + c; }
                else { const int c = d == 0 ? st - CTX / S5TC : SEQ / S5TC - 1 - (st - CTX / S5TC); row = b * (SEQ / S5TC) + c; }
                rows[q] = row; zr[q] = Z[(size_t)row * 256]; zi[q] = Z[(size_t)row * 256 + 64];
            }
        }
        if (i < 6) {
            const int s = 22 * i;
#pragma unroll
            for (int q = 0; q < 22; ++q) {
                u[(size_t)(s + q) * (4 * 128 * 32)] = pk2(s0, s1);
                s0 = dd[q].x * s0 + bf2f(uu[q] & 0xffffu); s1 = dd[q].y * s1 + bf2f(uu[q] >> 16);
            }
        }
        if (has5) {
#pragma unroll
            for (int q = 0; q < 33; ++q) {
                H[(size_t)rows[q] * S5K] = (bf16_t)f2bf(hr); H[(size_t)rows[q] * S5K + 64] = (bf16_t)f2bf(hi);
                const float nr = ar * hr - ai * hi + zr[q], ni = ar * hi + ai * hr + zi[q];
                hr = nr; hi = ni;
            }
        }
    }
}
struct RouteRec { int eid[2]; float gate[2]; int lrank[2]; int pos[2]; };
constexpr int RT_PITCH = 1032;
__device__ __forceinline__ void split_bf16(float x, unsigned& hi, unsigned& lo) { hi = f2bf(x); lo = f2bf(x - bf2f(hi)); }
__device__ __forceinline__ void router_phase(const Frame& F, int layer, int conv_kind  , bool skip_loop = false) {
    LAS bf16_t* thi = (LAS bf16_t*)F.lds;
    LAS bf16_t* tlo = thi + 16 * RT_PITCH;
    LAS float* part = (LAS float*)(F.lds + 66048);
    LAS float* lgt = (LAS float*)(F.lds + 66048 + 24576);
    LAS int* hist = (LAS int*)(F.lds + 66048 + 24576 + 3072);
    const int lane = FLANE, w = F.wave, fr = lane & 15, fq = lane >> 4;
    const float* wg = F.a->in[I_WG] + (size_t)layer * 1024 * 4; const float* we = F.a->in[I_WE] + (size_t)layer * 1024 * 32;
    const float* bg = F.a->in[I_BG] + layer * 4; const float* be = F.a->in[I_BE] + layer * 32;
    const float* mod = WSP(float, M_MOD) + (size_t)layer * 5 * 6144;
    bf16x8 bhi[4][3], blo[4][3];
#pragma unroll
    for (int kc = 0; kc < 4; ++kc)
#pragma unroll
        for (int nt = 0; nt < 3; ++nt) {
            const int n = 16 * nt + fr; unsigned h2[4], l2[4];
#pragma unroll
            for (int e = 0; e < 4; ++e) {
                unsigned hh[2], ll[2];
#pragma unroll
                for (int q = 0; q < 2; ++q) { const int k = 128 * w + 32 * kc + 8 * fq + 2 * e + q;
                    const float v = n < 4 ? wg[k * 4 + n] : (n < 36 ? we[k * 32 + (n - 4)] : 0.f); split_bf16(v, hh[q], ll[q]); }
                h2[e] = hh[0] | (hh[1] << 16); l2[e] = ll[0] | (ll[1] << 16);
            }
            bhi[kc][nt] = __builtin_bit_cast(bf16x8, (u32x4){h2[0], h2[1], h2[2], h2[3]}); blo[kc][nt] = __builtin_bit_cast(bf16x8, (u32x4){l2[0], l2[1], l2[2], l2[3]});
        }
    if (FTID < 32) hist[FTID] = 0;
    const int T0 = layer == 0 ? 0 : NCTX, ngroups = skip_loop ? 0 : (NTOK - T0) / 16;
    RouteRec* rr = WSP(RouteRec, M_ROUTE);
    u32x4 vpre[2][2];
    if (F.bid < ngroups) {
#pragma unroll
        for (int r2 = 0; r2 < 2; ++r2) { const u32x4* xr = (const u32x4*)(WSP(bf16_t, B_X1) + (size_t)(T0 + F.bid * 16 + 2 * w + r2) * 1024) + lane;
#pragma unroll
            for (int j = 0; j < 2; ++j) vpre[r2][j] = xr[64 * j]; }
    }
    float bias0, bias1;
    { const int n0 = FTID % 48, n1 = (FTID + 512) % 48;
      bias0 = n0 < 4 ? bg[n0] : (n0 < 36 ? be[n0 - 4] : 0.f); bias1 = n1 < 4 ? bg[n1] : (n1 < 36 ? be[n1 - 4] : 0.f); }
    LAS float* cscr = (LAS float*)(F.lds + 93824) + w * (32 * 33);
    LAS float* lmod = (LAS float*)(F.lds + 93824 + 8 * 4224);
    const int cstride = F.G * 8;
    ConvSt cs; cs.kind = conv_kind < 0 ? 0 : conv_kind; cs.n = conv_kind < 0 ? 0 : moe_conv_count(conv_kind); cs.cit = F.bid * 8 + w; cs.half = 0; cs.ldw = 0; cs.K = 0; cs.src = nullptr; cs.dst = nullptr;
    ConvSet qa, qb; qa.dst = nullptr; qa.K = 0; qa.half = 0; qa.pend = 0; qb = qa;
    float wva[16], wvb[16];
    int cur_b5 = -1;
    for (int gi = F.bid; gi < ngroups; gi += F.G) {
        LDS_BARRIER();
        { const int b5 = tok_b5(T0 + gi * 16);
          if (b5 != cur_b5) { cur_b5 = b5; *(LAS f32x4*)(lmod + 4 * FTID) = *(const f32x4*)(mod + b5 * 6144 + 3 * 1024 + 4 * FTID); LDS_BARRIER(); } }
        CONV_SLOT(qa, wva);
#pragma unroll
        for (int r2 = 0; r2 < 2; ++r2) {
            const int row = 2 * w + r2, T = T0 + gi * 16 + row;
            f32x4 va[2], vb[2]; float s = 0.f;
#pragma unroll
            for (int j = 0; j < 2; ++j) { unpack8f(vpre[r2][j], va[j], vb[j]);
                s += (va[j].x * va[j].x + va[j].y * va[j].y) + (va[j].z * va[j].z + va[j].w * va[j].w) + (vb[j].x * vb[j].x + vb[j].y * vb[j].y) + (vb[j].z * vb[j].z + vb[j].w * vb[j].w); }
            const float rinv = rsqrtf(wave_sum(s) * (1.f / 1024.f) + EPS);
            u32x4* o16 = (u32x4*)(WSP(bf16_t, B_ABUF) + (size_t)T * 1024) + lane;
#pragma unroll
            for (int j = 0; j < 2; ++j) {
                const LAS float* ms = lmod + 8 * lane + 512 * j;
                const f32x4 ha = va[j] * rinv * (*(const LAS f32x4*)(ms + 1024) + 1.f) + *(const LAS f32x4*)ms, hb = vb[j] * rinv * (*(const LAS f32x4*)(ms + 1028) + 1.f) + *(const LAS f32x4*)(ms + 4);
                unsigned h0, h1, h2, h3, h4, h5, h6, h7, l0, l1, l2, l3, l4, l5, l6, l7;
                split_bf16(ha.x, h0, l0); split_bf16(ha.y, h1, l1); split_bf16(ha.z, h2, l2); split_bf16(ha.w, h3, l3);
                split_bf16(hb.x, h4, l4); split_bf16(hb.y, h5, l5); split_bf16(hb.z, h6, l6); split_bf16(hb.w, h7, l7);
                const u32x4 hw = (u32x4){h0 | (h1 << 16), h2 | (h3 << 16), h4 | (h5 << 16), h6 | (h7 << 16)}, lw = (u32x4){l0 | (l1 << 16), l2 | (l3 << 16), l4 | (l5 << 16), l6 | (l7 << 16)};
                o16[64 * j] = hw;
                *(LAS u32x4*)(thi + row * RT_PITCH + 8 * lane + 512 * j) = hw;
                *(LAS u32x4*)(tlo + row * RT_PITCH + 8 * lane + 512 * j) = lw;
            }
            if (gi + F.G < ngroups) { const u32x4* xn = (const u32x4*)(WSP(bf16_t, B_X1) + (size_t)(T + F.G * 16) * 1024) + lane;
#pragma unroll
                for (int j = 0; j < 2; ++j) vpre[r2][j] = xn[64 * j]; }
        }
        LDS_BARRIER();
        f32x4 acc[3] = {(f32x4){0.f, 0.f, 0.f, 0.f}, (f32x4){0.f, 0.f, 0.f, 0.f}, (f32x4){0.f, 0.f, 0.f, 0.f}};
#pragma unroll
        for (int kc = 0; kc < 4; ++kc) {
            const bf16x8 ah = *(const LAS bf16x8*)(thi + fr * RT_PITCH + 128 * w + 32 * kc + 8 * fq), al = *(const LAS bf16x8*)(tlo + fr * RT_PITCH + 128 * w + 32 * kc + 8 * fq);
#pragma unroll
            for (int nt = 0; nt < 3; ++nt) {
                acc[nt] = __builtin_amdgcn_mfma_f32_16x16x32_bf16(ah, bhi[kc][nt], acc[nt], 0, 0, 0);
                acc[nt] = __builtin_amdgcn_mfma_f32_16x16x32_bf16(ah, blo[kc][nt], acc[nt], 0, 0, 0);
                acc[nt] = __builtin_amdgcn_mfma_f32_16x16x32_bf16(al, bhi[kc][nt], acc[nt], 0, 0, 0);
            }
        }
#pragma unroll
        for (int nt = 0; nt < 3; ++nt)
#pragma unroll
            for (int i = 0; i < 4; ++i) part[(w * 16 + 4 * fq + i) * 48 + 16 * nt + fr] = acc[nt][i];
        CONV_SLOT(qb, wvb);
        LDS_BARRIER();
        { float s = bias0;
#pragma unroll
          for (int ww = 0; ww < 8; ++ww) s += part[ww * 768 + FTID];
          lgt[FTID] = s;
          if (FTID < 256) { float s1 = bias1;
#pragma unroll
            for (int ww = 0; ww < 8; ++ww) s1 += part[ww * 768 + 512 + FTID];
            lgt[512 + FTID] = s1; } }
        LDS_BARRIER();
        if (FTID < 16) {
            const int T = T0 + gi * 16 + FTID; const LAS float* l = lgt + FTID * 48;
            float lg[4]; int grp = 0; float mx = -3.0e38f;
#pragma unroll
            for (int q = 0; q < 4; ++q) { lg[q] = l[q]; if (lg[q] > mx) { mx = lg[q]; grp = q; } }
            float zs = 0.f;
#pragma unroll
            for (int q = 0; q < 4; ++q) zs += __expf(lg[q] - mx);
            const float gw = 1.f / zs;
            float le[8]; int i1 = 0; float m1 = -3.0e38f;
#pragma unroll
            for (int q = 0; q < 8; ++q) { const float v = l[4 + grp * 8 + q];
                le[q] = v; if (v > m1) { m1 = v; i1 = q; } }
            int i2 = 0; float m2 = -3.0e38f;
#pragma unroll
            for (int q = 0; q < 8; ++q) { if (q != i1 && le[q] > m2) { m2 = le[q]; i2 = q; } }
            const float e2 = __expf(m2 - m1), den = 1.f + e2;
            RouteRec rec;
            rec.eid[0] = grp * 8 + i1; rec.eid[1] = grp * 8 + i2; rec.gate[0] = gw / den; rec.gate[1] = gw * e2 / den;
            rec.lrank[0] = atomicAdd((int*)&hist[rec.eid[0]], 1); rec.lrank[1] = atomicAdd((int*)&hist[rec.eid[1]], 1);
            rec.pos[0] = 0; rec.pos[1] = 0;
            rr[T] = rec;
        }
    }
    while (qa.pend || qb.pend || cs.cit < cs.n) { CONV_SLOT(qa, wva); CONV_SLOT(qb, wvb); }
    __syncthreads();
    if (FTID < 32) WSP(int, M_HIST)[F.bid * 32 + FTID] = hist[FTID];
}

__device__ __forceinline__ void placement_phase(const Frame& F, int layer) {
    LAS int* base = (LAS int*)F.lds;
    LAS int* tot = base + 256 * 32;
    LAS int* pstart = tot + 32;
    const int* hist = WSP(int, M_HIST);
    __syncthreads();
    if (F.G == 256) {
        LAS int* segs = pstart + 40;
        const int e = FTID & 31, seg = FTID >> 5;
        int vals[16]; int part = 0;
#pragma unroll
        for (int j = 0; j < 16; ++j) vals[j] = hist[(seg * 16 + j) * 32 + e];
#pragma unroll
        for (int j = 0; j < 16; ++j) part += vals[j];
        segs[seg * 32 + e] = part;
        __syncthreads();
        int run = 0;
#pragma unroll
        for (int s2 = 0; s2 < 16; ++s2) { const int v = segs[s2 * 32 + e]; run += s2 < seg ? v : 0; }
#pragma unroll
        for (int j = 0; j < 16; ++j) { base[(seg * 16 + j) * 32 + e] = run; run += vals[j]; }
        if (seg == 15) tot[e] = run;
    } else if (FTID < 32) { int run = 0; for (int bk = 0; bk < F.G; ++bk) { base[bk * 32 + FTID] = run; run += hist[bk * 32 + FTID]; } tot[FTID] = run; }
    __syncthreads();
    if (FTID == 0) { int run = 0; for (int e = 0; e < 32; ++e) { pstart[e] = run; run += (tot[e] + 255) / 256 * 256; } pstart[32] = run; }
    __syncthreads();
    int* tokbuf = WSP(int, M_TOKBUF); float* gatebuf = WSP(float, M_GATEBUF); int* tiles = WSP(int, M_TILES);
    if (F.bid == 0) {
        if (FTID == 0) tiles[0] = pstart[32] / 256;
        if (FTID < 32) { const int t0 = pstart[FTID] / 256, t1 = pstart[FTID + 1] / 256; for (int t = t0; t < t1; ++t) tiles[1 + t] = FTID; }
    }
    for (int e = F.bid; e < 32; e += F.G) { const int p0 = pstart[e] + tot[e], p1 = pstart[e + 1]; for (int p = p0 + FTID; p < p1; p += 512) { tokbuf[p] = 0; gatebuf[p] = 0.f; } }
    const int T0 = layer == 0 ? 0 : NCTX, ngroups = (NTOK - T0) / 16;
    RouteRec* rr = WSP(RouteRec, M_ROUTE);
    for (int i = F.bid * 512 + FTID; i < (NTOK - T0) * 2; i += F.G * 512) {
        const int T = T0 + (i >> 1), k = i & 1, gi = (T - T0) >> 4, owner = gi % F.G;
        const int e = rr[T].eid[k], pos = pstart[e] + base[owner * 32 + e] + rr[T].lrank[k];
        rr[T].pos[k] = pos; tokbuf[pos] = T; gatebuf[pos] = rr[T].gate[k];
    }
    (void)ngroups;
}

__device__ __forceinline__ void combine_norm1_phase(const Frame& F) {
    const int gw = F.bid * 8 + F.wave, NGW = F.G * 8, lane = FLANE;
    const float* mod0 = WSP(float, M_MOD); const float* mod1 = mod0 + 5 * 6144;
    const RouteRec* rr = WSP(RouteRec, M_ROUTE); const bf16_t* YB = WSP(bf16_t, B_YB);
    int pn[2][2] = {{0, 0}, {0, 0}}; float gn[2][2] = {{0.f, 0.f}, {0.f, 0.f}};
#pragma unroll
    for (int e = 0; e < 2; ++e) { const int T = gw + e * NGW; if (T < NTOK) { pn[e][0] = rr[T].pos[0]; pn[e][1] = rr[T].pos[1]; gn[e][0] = rr[T].gate[0]; gn[e][1] = rr[T].gate[1]; } }
    for (int T0 = gw; T0 < NTOK; T0 += 2 * NGW) {
        u32x4 xv[2][2], ya[2][2], yb[2][2]; float g0[2], g1[2]; bool ok[2]; u32x4* xr[2];
#pragma unroll
        for (int e = 0; e < 2; ++e) {
            const int T = T0 + e * NGW; ok[e] = T < NTOK; const int Tc = ok[e] ? T : T0;
            xr[e] = (u32x4*)(WSP(bf16_t, B_X1) + (size_t)Tc * 1024) + lane;
            const u32x4* y0 = (const u32x4*)(YB + (size_t)pn[e][0] * 1024) + lane;
            const u32x4* y1 = (const u32x4*)(YB + (size_t)pn[e][1] * 1024) + lane;
            g0[e] = gn[e][0]; g1[e] = gn[e][1];
#pragma unroll
            for (int j = 0; j < 2; ++j) { xv[e][j] = xr[e][64 * j]; ya[e][j] = y0[64 * j]; yb[e][j] = y1[64 * j]; }
        }
#pragma unroll
        for (int e = 0; e < 2; ++e) { const int Tn = T0 + (2 + e) * NGW; if (Tn < NTOK) { pn[e][0] = rr[Tn].pos[0]; pn[e][1] = rr[Tn].pos[1]; gn[e][0] = rr[Tn].gate[0]; gn[e][1] = rr[Tn].gate[1]; } }
#pragma unroll
        for (int e = 0; e < 2; ++e) {
            const int T = T0 + e * NGW;
            if (ok[e]) {
                const int b5 = tok_b5(T);
                const f32x4* g2 = (const f32x4*)(mod0 + b5 * 6144 + 5 * 1024) + 2 * lane;
                f32x4 va[2], vb[2]; float s = 0.f; const float gt0 = g0[e], gt1 = g1[e];
#pragma unroll
                for (int j = 0; j < 2; ++j) {
                    f32x4 xa, xb, a0, a1, c0, c1; unpack8f(xv[e][j], xa, xb); unpack8f(ya[e][j], a0, a1); unpack8f(yb[e][j], c0, c1);
                    va[j] = xa + g2[128 * j] * (gt0 * a0 + gt1 * c0); vb[j] = xb + g2[128 * j + 1] * (gt0 * a1 + gt1 * c1);
                    xr[e][64 * j] = pack8(va[j], vb[j]);
                    s += (va[j].x * va[j].x + va[j].y * va[j].y) + (va[j].z * va[j].z + va[j].w * va[j].w) + (vb[j].x * vb[j].x + vb[j].y * vb[j].y) + (vb[j].z * vb[j].z + vb[j].w * vb[j].w);
                }
                const float rinv = rsqrtf(wave_sum(s) * (1.f / 1024.f) + EPS);
                const f32x4* msh = (const f32x4*)(mod1 + b5 * 6144) + 2 * lane; const f32x4* msl = (const f32x4*)(mod1 + b5 * 6144 + 1024) + 2 * lane;
                u32x4* o16 = (u32x4*)(WSP(bf16_t, B_ABUF) + (size_t)T * 1024) + lane;
#pragma unroll
                for (int j = 0; j < 2; ++j)
                    o16[64 * j] = pack8(va[j] * rinv * (msl[128 * j] + 1.f) + msh[128 * j], vb[j] * rinv * (msl[128 * j + 1] + 1.f) + msh[128 * j + 1]);
            }
        }
    }
}
__device__ __forceinline__ void final_phase(const Frame& F) {
    const int gw = F.bid * 8 + F.wave, NGW = F.G * 8, lane = FLANE;
    const float* mod1 = WSP(float, M_MOD) + 5 * 6144;
    const RouteRec* rr = WSP(RouteRec, M_ROUTE); const bf16_t* YB = WSP(bf16_t, B_YB);
    int pn[2][2] = {{0, 0}, {0, 0}}; float gn[2][2] = {{0.f, 0.f}, {0.f, 0.f}};
#pragma unroll
    for (int e = 0; e < 2; ++e) { const int Tl = gw + e * NGW; if (Tl < NLAT) { const RouteRec* q = rr + NCTX + Tl; pn[e][0] = q->pos[0]; pn[e][1] = q->pos[1]; gn[e][0] = q->gate[0]; gn[e][1] = q->gate[1]; } }
    for (int Tl0 = gw; Tl0 < NLAT; Tl0 += 2 * NGW) {
        u32x4 xv[2][2], ya[2][2], yb[2][2]; float g0[2], g1[2]; bool ok[2];
#pragma unroll
        for (int e = 0; e < 2; ++e) {
            const int Tl = Tl0 + e * NGW; ok[e] = Tl < NLAT; const int Tc = ok[e] ? Tl : Tl0;
            const u32x4* xr = (const u32x4*)(WSP(bf16_t, B_X1) + (size_t)(NCTX + Tc) * 1024) + lane;
            const u32x4* y0 = (const u32x4*)(YB + (size_t)pn[e][0] * 1024) + lane;
            const u32x4* y1 = (const u32x4*)(YB + (size_t)pn[e][1] * 1024) + lane;
            g0[e] = gn[e][0]; g1[e] = gn[e][1];
#pragma unroll
            for (int j = 0; j < 2; ++j) { xv[e][j] = xr[64 * j]; ya[e][j] = y0[64 * j]; yb[e][j] = y1[64 * j]; }
        }
#pragma unroll
        for (int e = 0; e < 2; ++e) { const int Tn = Tl0 + (2 + e) * NGW; if (Tn < NLAT) { const RouteRec* q = rr + NCTX + Tn; pn[e][0] = q->pos[0]; pn[e][1] = q->pos[1]; gn[e][0] = q->gate[0]; gn[e][1] = q->gate[1]; } }
#pragma unroll
        for (int e = 0; e < 2; ++e) {
            const int Tl = Tl0 + e * NGW;
            if (ok[e]) {
                const f32x4* g2 = (const f32x4*)(mod1 + (Tl / SEQ) * 6144 + 5 * 1024) + 2 * lane;
                f32x4* o = (f32x4*)(F.a->out + (size_t)Tl * 1024) + 2 * lane;
                const float gt0 = g0[e], gt1 = g1[e];
#pragma unroll
                for (int j = 0; j < 2; ++j) {
                    f32x4 xa, xb, a0, a1, c0, c1; unpack8f(xv[e][j], xa, xb); unpack8f(ya[e][j], a0, a1); unpack8f(yb[e][j], c0, c1);
                    o[128 * j] = xa + g2[128 * j] * (gt0 * a0 + gt1 * c0); o[128 * j + 1] = xb + g2[128 * j + 1] * (gt0 * a1 + gt1 * c1);
                }
            }
        }
    }
}
#ifndef FFT_HD
#define FFT_HD __device__ __forceinline__
#endif
typedef float cpx __attribute__((ext_vector_type(2)));
#ifndef FFT_OPAQUE
#define FFT_OPAQUE(x) asm volatile("" : "+v"(x))
#endif
#define W16C(k) ((k) == 0 ? 1.0f : (k) == 1 ? 0.9238795325112867f : (k) == 2 ? 0.7071067811865476f : (k) == 3 ? 0.3826834323650898f : (k) == 4 ? 0.0f : (k) == 5 ? -0.3826834323650898f : (k) == 6 ? -0.7071067811865476f : (k) == 7 ? -0.9238795325112867f : (k) == 8 ? -1.0f : -0.9238795325112867f)
#define W16S(k) ((k) == 0 ? 0.0f : (k) == 1 ? -0.3826834323650898f : (k) == 2 ? -0.7071067811865476f : (k) == 3 ? -0.9238795325112867f : (k) == 4 ? -1.0f : (k) == 5 ? -0.9238795325112867f : (k) == 6 ? -0.7071067811865476f : (k) == 7 ? -0.3826834323650898f : (k) == 8 ? 0.0f : 0.3826834323650898f)
#if defined(__HIP_DEVICE_COMPILE__)
FFT_HD cpx cmul(cpx a, cpx b) {
    cpx t, r;
    asm("v_pk_mul_f32 %0, %1, %2 op_sel:[1,1] op_sel_hi:[1,0]" : "=v"(t) : "v"(a), "v"(b));
    asm("v_pk_fma_f32 %0, %1, %2, %3 op_sel:[0,0,0] op_sel_hi:[0,1,1] neg_lo:[0,0,1]" : "=v"(r) : "v"(a), "v"(b), "v"(t));
    return r;
}
FFT_HD cpx cmulc(cpx a, cpx b) {
    cpx t, r;
    asm("v_pk_mul_f32 %0, %1, %2 op_sel:[1,1] op_sel_hi:[1,0]" : "=v"(t) : "v"(a), "v"(b));
    asm("v_pk_fma_f32 %0, %1, %2, %3 op_sel:[0,0,0] op_sel_hi:[0,1,1] neg_hi:[0,1,0]" : "=v"(r) : "v"(a), "v"(b), "v"(t));
    return r;
}
FFT_HD cpx cadd_i(cpx a, cpx b) { cpx r; asm("v_pk_add_f32 %0, %1, %2 op_sel:[0,1] op_sel_hi:[1,0] neg_lo:[0,1]" : "=v"(r) : "v"(a), "v"(b)); return r; }
FFT_HD cpx csub_i(cpx a, cpx b) { cpx r; asm("v_pk_add_f32 %0, %1, %2 op_sel:[0,1] op_sel_hi:[1,0] neg_hi:[0,1]" : "=v"(r) : "v"(a), "v"(b)); return r; }
#else
FFT_HD cpx cmul(cpx a, cpx b) { return (cpx){a.x * b.x - a.y * b.y, a.x * b.y + a.y * b.x}; }
FFT_HD cpx cmulc(cpx a, cpx b) { return (cpx){a.x * b.x + a.y * b.y, a.y * b.x - a.x * b.y}; }
FFT_HD cpx cadd_i(cpx a, cpx b) { return (cpx){a.x - b.y, a.y + b.x}; }
FFT_HD cpx csub_i(cpx a, cpx b) { return (cpx){a.x + b.y, a.y - b.x}; }
#endif
FFT_HD int fft_ph(int p) { return p + (p >> 4); }
constexpr int FFT_LDS_ELEMS = 16384 + 1024;
template <bool INV> FFT_HD void dft4(cpx& a, cpx& b, cpx& c, cpx& d) {
    const cpx s0 = a + c, s1 = a - c, s2 = b + d, s3 = b - d;
    a = s0 + s2; c = s0 - s2;
    if (!INV) { b = csub_i(s1, s3); d = cadd_i(s1, s3); }
    else      { b = cadd_i(s1, s3); d = csub_i(s1, s3); }
}
template <class Buf, class Tw>
FFT_HD void fft_fwd_pass_r4(Buf buf, Tw tw, int tid, int nthreads) {
    FFT_OPAQUE(tid);
#pragma unroll 1
    for (int j = tid; j < 4096; j += nthreads) {
        const int pj = fft_ph(j);
        cpx v0 = buf[pj], v1 = buf[pj + 4352], v2 = buf[pj + 8704], v3 = buf[pj + 13056];
        dft4<false>(v0, v1, v2, v3);
        const cpx w1 = tw[j], w2 = cmul(w1, w1), w3 = cmul(w2, w1);
        buf[pj] = v0; buf[pj + 4352] = cmul(v1, w1); buf[pj + 8704] = cmul(v2, w2); buf[pj + 13056] = cmul(v3, w3);
    }
}
template <class Buf, class Tw>
FFT_HD void fft_inv_pass_r4(Buf buf, Tw tw, int tid, int nthreads) {
    FFT_OPAQUE(tid);
#pragma unroll 1
    for (int j = tid; j < 4096; j += nthreads) {
        const cpx w1 = tw[j], w2 = cmul(w1, w1), w3 = cmul(w2, w1);
        const int pj = fft_ph(j);
        cpx v0 = buf[pj], v1 = cmulc(buf[pj + 4352], w1), v2 = cmulc(buf[pj + 8704], w2), v3 = cmulc(buf[pj + 13056], w3);
        dft4<true>(v0, v1, v2, v3);
        buf[pj] = v0; buf[pj + 4352] = v1; buf[pj + 8704] = v2; buf[pj + 13056] = v3;
    }
}
typedef float kf4_t __attribute__((ext_vector_type(4)));
template <int N_, class Buf, class Tw>
FFT_HD void fft_fwd_pass_r16(Buf buf, Tw tw, int tid, int nthreads, const kf4_t* kfmul = nullptr, kf4_t* kfout = nullptr) {
    FFT_OPAQUE(tid);
    constexpr int S = N_ / 16, TWS1 = 16384 / N_, TWS2 = 16384 / (N_ / 4);
#pragma unroll 2
    for (int it = tid; it < 1024; it += nthreads) {
        kf4_t kq[8];
        if (N_ == 16 && kfmul) {
#pragma unroll
            for (int q = 0; q < 8; ++q) kq[q] = kfmul[q * 1024 + it];
        }
        const int j0 = it % S, blk = it / S, base = blk * N_ + j0, pb = fft_ph(base);
        constexpr int PS = S + S / 16;
        cpx v[16];
#pragma unroll
        for (int q = 0; q < 16; ++q) v[q] = buf[pb + q * PS];
#pragma unroll
        for (int i = 0; i < 4; ++i) {
            dft4<false>(v[i], v[4 + i], v[8 + i], v[12 + i]);
            if (N_ > 16) { const cpx w1 = tw[((j0 + i * S) * TWS1) & 16383], w2 = cmul(w1, w1), w3 = cmul(w2, w1);
                v[4 + i] = cmul(v[4 + i], w1); v[8 + i] = cmul(v[8 + i], w2); v[12 + i] = cmul(v[12 + i], w3); }
            else if (i > 0) { const cpx w1 = (cpx){W16C(i), W16S(i)}, w2 = (cpx){W16C(2 * i), W16S(2 * i)}, w3 = (cpx){W16C(3 * i), W16S(3 * i)};
                v[4 + i] = cmul(v[4 + i], w1); v[8 + i] = cmul(v[8 + i], w2); v[12 + i] = cmul(v[12 + i], w3); }
        }
#pragma unroll
        for (int m = 0; m < 4; ++m) {
            dft4<false>(v[4 * m], v[4 * m + 1], v[4 * m + 2], v[4 * m + 3]);
            if (N_ > 16) { const cpx w1 = tw[(j0 * TWS2) & 16383], w2 = cmul(w1, w1), w3 = cmul(w2, w1);
                v[4 * m + 1] = cmul(v[4 * m + 1], w1); v[4 * m + 2] = cmul(v[4 * m + 2], w2); v[4 * m + 3] = cmul(v[4 * m + 3], w3); }
        }
        if (N_ == 16 && kfmul) {
#pragma unroll
            for (int q = 0; q < 16; ++q) v[q] = cmul(v[q], (cpx){kq[q >> 1][2 * (q & 1)], kq[q >> 1][2 * (q & 1) + 1]});
        }
        if (N_ == 16 && kfout) {
            const float sc = 1.f / 16384.f;
#pragma unroll
            for (int q = 0; q < 8; ++q) kfout[q * 1024 + it] = (kf4_t){v[2 * q].x * sc, v[2 * q].y * sc, v[2 * q + 1].x * sc, v[2 * q + 1].y * sc};
        } else {
#pragma unroll
            for (int q = 0; q < 16; ++q) buf[pb + q * PS] = v[q];
        }
    }
}
template <int N_, class Buf, class Tw>
FFT_HD void fft_inv_pass_r16(Buf buf, Tw tw, int tid, int nthreads) {
    FFT_OPAQUE(tid);
    constexpr int S = N_ / 16, TWS1 = 16384 / N_, TWS2 = 16384 / (N_ / 4);
#pragma unroll 2
    for (int it = tid; it < 1024; it += nthreads) {
        const int j0 = it % S, blk = it / S, base = blk * N_ + j0, pb = fft_ph(base);
        constexpr int PS = S + S / 16;
        cpx v[16];
#pragma unroll
        for (int q = 0; q < 16; ++q) v[q] = buf[pb + q * PS];
#pragma unroll
        for (int m = 0; m < 4; ++m) {
            if (N_ > 16) { const cpx w1 = tw[(j0 * TWS2) & 16383], w2 = cmul(w1, w1), w3 = cmul(w2, w1);
                v[4 * m + 1] = cmulc(v[4 * m + 1], w1); v[4 * m + 2] = cmulc(v[4 * m + 2], w2); v[4 * m + 3] = cmulc(v[4 * m + 3], w3); }
            dft4<true>(v[4 * m], v[4 * m + 1], v[4 * m + 2], v[4 * m + 3]);
        }
#pragma unroll
        for (int i = 0; i < 4; ++i) {
            if (N_ > 16) { const cpx w1 = tw[((j0 + i * S) * TWS1) & 16383], w2 = cmul(w1, w1), w3 = cmul(w2, w1);
                v[4 + i] = cmulc(v[4 + i], w1); v[8 + i] = cmulc(v[8 + i], w2); v[12 + i] = cmulc(v[12 + i], w3); }
            else if (i > 0) { const cpx w1 = (cpx){W16C(i), W16S(i)}, w2 = (cpx){W16C(2 * i), W16S(2 * i)}, w3 = (cpx){W16C(3 * i), W16S(3 * i)};
                v[4 + i] = cmulc(v[4 + i], w1); v[8 + i] = cmulc(v[8 + i], w2); v[12 + i] = cmulc(v[12 + i], w3); }
            dft4<true>(v[i], v[4 + i], v[8 + i], v[12 + i]);
        }
#pragma unroll
        for (int q = 0; q < 16; ++q) buf[pb + q * PS] = v[q];
    }
}
__device__ __forceinline__ void hf_unit(const Frame& F, int u) {
    LAS float* h3 = (LAS float*)F.lds;
    const int tb = u >> 1, t0 = tb * 64, col0 = (u & 1) * 512 + 64 * F.wave, lane = FLANE, fr = lane & 15, fq = lane >> 4;
    __syncthreads();
    for (int i = FTID; i < 64 * 64; i += 512) h3[(i >> 6) * 66 + (i & 63)] = WSP(float, M_H3)[(size_t)t0 * 64 + i];
    __syncthreads();
    f32x4 acc[4][4];
#pragma unroll
    for (int mt = 0; mt < 4; ++mt)
#pragma unroll
        for (int nt = 0; nt < 4; ++nt) acc[mt][nt] = (f32x4){0.f, 0.f, 0.f, 0.f};
    const float* fw4 = F.a->in[I_FW4] + col0 + fr;
    float bw[16][4];
#pragma unroll
    for (int ks = 0; ks < 16; ++ks)
#pragma unroll
        for (int nt = 0; nt < 4; ++nt) bw[ks][nt] = fw4[(size_t)(4 * ks + fq) * 1024 + 16 * nt];
#pragma unroll
    for (int ks = 0; ks < 16; ++ks) {
        float a[4];
#pragma unroll
        for (int mt = 0; mt < 4; ++mt) a[mt] = h3[(16 * mt + fr) * 66 + 4 * ks + fq];
#pragma unroll
        for (int mt = 0; mt < 4; ++mt)
#pragma unroll
            for (int nt = 0; nt < 4; ++nt) acc[mt][nt] = __builtin_amdgcn_mfma_f32_16x16x4f32(a[mt], bw[ks][nt], acc[mt][nt], 0, 0, 0);
    }
#pragma unroll
    for (int nt = 0; nt < 4; ++nt) {
        const int col = col0 + 16 * nt + fr, ch = col & 511;
        const float delta = 4.605170185988091f * (1.f / 1.5f + (float)ch * ((1.f / 0.3f - 1.f / 1.5f) / 511.f));
        float* o = WSP(float, B_HF) + (size_t)col * 8192 + t0 + 4 * fq;
#pragma unroll
        for (int mt = 0; mt < 4; ++mt) { f32x4 r;
#pragma unroll
            for (int i = 0; i < 4; ++i) r[i] = acc[mt][nt][i] * __expf(-(float)(t0 + 16 * mt + 4 * fq + i) * (1.f / 8191.f) * delta);
            *(f32x4*)(o + 16 * mt) = r; }
    }
}
struct TwLds { const LAS cpx* wa; const LAS cpx* wb; __device__ __forceinline__ cpx operator[](int k) const { return cmul(wa[k >> 7], wb[k & 127]); } };
constexpr int TW_LDS_OFF = FFT_LDS_ELEMS * 8;
__device__ __forceinline__ TwLds tw_lds_fill(const Frame& F, bool fill = true) {
    LAS cpx* wa = (LAS cpx*)(F.lds + TW_LDS_OFF); LAS cpx* wb = wa + 128; const cpx* tw = WSP(cpx, M_TW);
    if (fill) { if (FTID < 128) wa[FTID] = tw[FTID * 128]; else if (FTID < 256) wb[FTID - 128] = tw[FTID - 128]; }
    return TwLds{wa, wb};
}
__device__ __forceinline__ void fft_fwd_all(LAS cpx* buf, const TwLds tw, int tid) {
    __syncthreads(); fft_fwd_pass_r4(buf, tw, tid, 512);
    __syncthreads(); fft_fwd_pass_r16<4096>(buf, tw, tid, 512);
    __syncthreads(); fft_fwd_pass_r16<256>(buf, tw, tid, 512);
    __syncthreads(); fft_fwd_pass_r16<16>(buf, tw, tid, 512);
    __syncthreads();
}
__device__ __forceinline__ void fft_inv_all(LAS cpx* buf, const TwLds tw, int tid) {
    __syncthreads(); fft_inv_pass_r16<16>(buf, tw, tid, 512);
    __syncthreads(); fft_inv_pass_r16<256>(buf, tw, tid, 512);
    __syncthreads(); fft_inv_pass_r16<4096>(buf, tw, tid, 512);
    __syncthreads(); fft_inv_pass_r4(buf, tw, tid, 512);
    __syncthreads();
}
__device__ __forceinline__ void kf_unit(const Frame& F, int ch, bool first = true) {
    LAS cpx* buf = (LAS cpx*)F.lds;
    __syncthreads();
    const TwLds tw = tw_lds_fill(F, first);
    const float* hf = WSP(float, B_HF) + (size_t)ch * 8192; const float* hb = WSP(float, B_HF) + (size_t)(512 + ch) * 8192;
    {
        const int p0 = 16 * FTID;
        f32x4 a[4];
#pragma unroll
        for (int q = 0; q < 4; ++q) a[q] = *(const f32x4*)(hf + p0 + 4 * q);
        float r[16];
#pragma unroll
        for (int i = 0; i < 16; ++i) { const int p = 8192 + p0 + i; r[i] = p > 8192 ? hb[FFTN - p] : 0.f; }
#pragma unroll
        for (int q = 0; q < 4; ++q)
#pragma unroll
            for (int i = 0; i < 4; ++i) buf[fft_ph(p0 + 4 * q + i)] = (cpx){a[q][i], 0.f};
#pragma unroll
        for (int i = 0; i < 16; ++i) buf[fft_ph(8192 + p0 + i)] = (cpx){r[i], 0.f};
    }
    __syncthreads(); fft_fwd_pass_r4(buf, tw, FTID, 512);
    __syncthreads(); fft_fwd_pass_r16<4096>(buf, tw, FTID, 512);
    __syncthreads(); fft_fwd_pass_r16<256>(buf, tw, FTID, 512);
    __syncthreads(); fft_fwd_pass_r16<16>(buf, tw, FTID, 512, nullptr, (kf4_t*)(WSP(cpx, B_KF) + (size_t)ch * FFTN));
}
__device__ __forceinline__ void hy_conv16(const bf16_t* z, int t0, float w0, float w1, float w2, float bias, float (&o)[16]) {
    const u32x4 a = *(const u32x4*)(z + t0), b = *(const u32x4*)(z + t0 + 8);
    float v[18];
    v[0] = t0 > 0 ? bf2f(z[t0 - 1]) : 0.f; v[17] = t0 + 16 < 8192 ? bf2f(z[t0 + 16]) : 0.f;
    const unsigned rw[8] = {a.x, a.y, a.z, a.w, b.x, b.y, b.z, b.w};
#pragma unroll
    for (int e = 0; e < 8; ++e) { v[1 + 2 * e] = bf2f(rw[e] & 0xffffu); v[2 + 2 * e] = bf2f(rw[e] >> 16); }
#pragma unroll
    for (int i = 0; i < 16; ++i) o[i] = bias + w0 * v[i] + w1 * v[i + 1] + w2 * v[i + 2];
}
__device__ __forceinline__ void hyconv_unit(const Frame& F, int u, int var, bool first = true) {
    LAS cpx* buf = (LAS cpx*)F.lds;
    __syncthreads();
    const TwLds tw = tw_lds_fill(F, first);
    const int ch = u >> 1, bp = u & 1, t0 = 16 * FTID;
    const bf16_t* Z = WSP(bf16_t, B_ZHT);
    const float* cw = F.a->in[I_CONVW]; const float* cb = F.a->in[I_CONVB];
    float w[3][3], bb[3];
#pragma unroll
    for (int g = 0; g < 3; ++g) { bb[g] = cb[g * 512 + ch];
#pragma unroll
        for (int j = 0; j < 3; ++j) w[g][j] = cw[j * 1536 + g * 512 + ch]; }
    const float hbias = F.a->in[I_HBIAS][ch];
    float uu[2][16];
#pragma unroll
    for (int i = 0; i < 16; ++i) { uu[0][i] = 0.f; uu[1][i] = 0.f; }
    if (var != 2) {
        float x1[16], vv[16];
        hy_conv16(Z + (size_t)(512 + ch) * NLAT + (2 * bp) * 8192, t0, w[1][0], w[1][1], w[1][2], bb[1], x1);
        hy_conv16(Z + (size_t)(1024 + ch) * NLAT + (2 * bp) * 8192, t0, w[2][0], w[2][1], w[2][2], bb[2], vv);
#pragma unroll
        for (int i = 0; i < 16; ++i) uu[0][i] = x1[i] * vv[i];
        hy_conv16(Z + (size_t)(512 + ch) * NLAT + (2 * bp + 1) * 8192, t0, w[1][0], w[1][1], w[1][2], bb[1], x1);
        hy_conv16(Z + (size_t)(1024 + ch) * NLAT + (2 * bp + 1) * 8192, t0, w[2][0], w[2][1], w[2][2], bb[2], vv);
#pragma unroll
        for (int i = 0; i < 16; ++i) { uu[1][i] = x1[i] * vv[i]; buf[fft_ph(t0 + i)] = (cpx){uu[0][i], uu[1][i]}; buf[fft_ph(8192 + t0 + i)] = (cpx){0.f, 0.f}; }
    }
    if (var != 1) {
        __syncthreads(); fft_fwd_pass_r4(buf, tw, FTID, 512);
        __syncthreads(); fft_fwd_pass_r16<4096>(buf, tw, FTID, 512);
        __syncthreads(); fft_fwd_pass_r16<256>(buf, tw, FTID, 512);
        __syncthreads(); fft_fwd_pass_r16<16>(buf, tw, FTID, 512, (const kf4_t*)(WSP(cpx, B_KF) + (size_t)ch * FFTN));
    }
    if (var != 1) fft_inv_all(buf, tw, FTID);
    bf16_t* o = WSP(bf16_t, B_HYT) + (size_t)ch * NLAT;
    if (var != 2)
#pragma unroll
    for (int q = 0; q < 2; ++q) {
        const int b = 2 * bp + q;
        float x0[16];
        hy_conv16(Z + (size_t)(ch) * NLAT + b * 8192, t0, w[0][0], w[0][1], w[0][2], bb[0], x0);
        float r[16];
#pragma unroll
        for (int i = 0; i < 16; ++i) { const cpx y = buf[fft_ph(t0 + i)]; r[i] = x0[i] * ((q == 0 ? y.x : y.y) + uu[q][i] * hbias); }
        u32x4 s0, s1;
        s0.x = pk2(r[0], r[1]); s0.y = pk2(r[2], r[3]); s0.z = pk2(r[4], r[5]); s0.w = pk2(r[6], r[7]);
        s1.x = pk2(r[8], r[9]); s1.y = pk2(r[10], r[11]); s1.z = pk2(r[12], r[13]); s1.w = pk2(r[14], r[15]);
        *(u32x4*)(o + b * 8192 + t0) = s0; *(u32x4*)(o + b * 8192 + t0 + 8) = s1;
    }
}
__device__ __forceinline__ void hy_transpose_item(const Frame& F, int it, LAS bf16_t* scr  ) {
    const int cb = it & 7, tb = it >> 3, lane = FLANE, r8 = lane >> 3, c8 = lane & 7;
    const bf16_t* src = WSP(bf16_t, B_HYT) + (size_t)(cb * 64 + r8) * NLAT + tb * 64 + 8 * c8;
    u32x4 v[8];
#pragma unroll
    for (int j = 0; j < 8; ++j) v[j] = *(const u32x4*)(src + (size_t)(8 * j) * NLAT);
#pragma unroll
    for (int j = 0; j < 8; ++j) *(LAS u32x4*)(scr + (r8 + 8 * j) * 72 + 8 * c8) = v[j];
    LDS_WAIT(); asm volatile("" ::: "memory");
    bf16_t* dst = WSP(bf16_t, B_MIX1) + (size_t)(tb * 64 + r8) * 1024 + 512 + cb * 64 + 8 * c8;
#pragma unroll
    for (int j = 0; j < 8; ++j) {
        unsigned w[4];
#pragma unroll
        for (int e = 0; e < 4; ++e) w[e] = (unsigned)scr[(8 * c8 + 2 * e) * 72 + r8 + 8 * j] | ((unsigned)scr[(8 * c8 + 2 * e + 1) * 72 + r8 + 8 * j] << 16);
        *(u32x4*)(dst + (size_t)(8 * j) * 1024) = (u32x4){w[0], w[1], w[2], w[3]};
    }
    LDS_WAIT(); asm volatile("" ::: "memory");
}

__device__ __forceinline__ void qknorm_row(bf16_t* row, const float* nw, float extra, int lane) {
    u32x4* p = (u32x4*)row + lane;
    const u32x4 raw = *p; const unsigned rw[4] = {raw.x, raw.y, raw.z, raw.w};
    float v[8]; float ss = 0.f;
#pragma unroll
    for (int e = 0; e < 4; ++e) { v[2 * e] = bf2f(rw[e] & 0xffffu); v[2 * e + 1] = bf2f(rw[e] >> 16); ss += v[2 * e] * v[2 * e] + v[2 * e + 1] * v[2 * e + 1]; }
    ss += __shfl_xor(ss, 1); ss += __shfl_xor(ss, 2); ss += __shfl_xor(ss, 4);
    const float rinv = rsqrtf(ss * (1.f / 64.f) + EPS) * extra;
    const f32x4 n0 = *(const f32x4*)(nw + 8 * (lane & 7)), n1 = *(const f32x4*)(nw + 8 * (lane & 7) + 4);
    u32x4 o; o.x = pk2(v[0] * rinv * n0[0], v[1] * rinv * n0[1]); o.y = pk2(v[2] * rinv * n0[2], v[3] * rinv * n0[3]);
    o.z = pk2(v[4] * rinv * n1[0], v[5] * rinv * n1[1]); o.w = pk2(v[6] * rinv * n1[2], v[7] * rinv * n1[3]);
    *p = o;
}
__device__ __forceinline__ void qknorm_phase(const Frame& F) {
    const int gw = F.bid * 8 + F.wave, NGW = F.G * 8, lane = FLANE;
    const float* qn = F.a->in[I_QN]; const float* kn = F.a->in[I_KN];
    const f32x4 q0 = *(const f32x4*)(qn + 8 * (lane & 7)), q1 = *(const f32x4*)(qn + 8 * (lane & 7) + 4);
    const f32x4 k0 = *(const f32x4*)(kn + 8 * (lane & 7)), k1 = *(const f32x4*)(kn + 8 * (lane & 7) + 4);
    for (int r0 = gw; r0 < NLAT + NTOK; r0 += 4 * NGW) {
        u32x4* p[4]; u32x4 raw[4]; bool isq[4], ok[4];
#pragma unroll
        for (int e = 0; e < 4; ++e) { const int r = r0 + e * NGW; ok[e] = r < NLAT + NTOK; const int rr = ok[e] ? r : r0; isq[e] = rr < NLAT;
            p[e] = (u32x4*)(isq[e] ? WSP(bf16_t, B_Q1) + (size_t)rr * 512 : WSP(bf16_t, B_K1) + (size_t)(rr - NLAT) * 512) + lane; raw[e] = *p[e]; }
#pragma unroll
        for (int e = 0; e < 4; ++e) {
            const unsigned rw[4] = {raw[e].x, raw[e].y, raw[e].z, raw[e].w};
            float v[8]; float ss = 0.f;
#pragma unroll
            for (int t = 0; t < 4; ++t) { v[2 * t] = bf2f(rw[t] & 0xffffu); v[2 * t + 1] = bf2f(rw[t] >> 16); ss += v[2 * t] * v[2 * t] + v[2 * t + 1] * v[2 * t + 1]; }
            ss += __shfl_xor(ss, 1); ss += __shfl_xor(ss, 2); ss += __shfl_xor(ss, 4);
            const float rinv = rsqrtf(ss * (1.f / 64.f) + EPS) * (isq[e] ? 0.125f : 1.f);
            const f32x4 n0 = isq[e] ? q0 : k0, n1 = isq[e] ? q1 : k1;
            u32x4 o; o.x = pk2(v[0] * rinv * n0[0], v[1] * rinv * n0[1]); o.y = pk2(v[2] * rinv * n0[2], v[3] * rinv * n0[3]);
            o.z = pk2(v[4] * rinv * n1[0], v[5] * rinv * n1[1]); o.w = pk2(v[6] * rinv * n1[2], v[7] * rinv * n1[3]);
            if (ok[e]) *p[e] = o;
        }
    }
}
constexpr int NA_KC_PITCH = 72;
constexpr int NA_VC_PITCH = 264;
struct NaKV { bf16x8 k[2][2]; u32x2 v[4][2]; };
__device__ __forceinline__ void na_load_local(NaKV& f, const bf16_t* K1, const bf16_t* VT1, size_t krow0, const bf16_t* vbase, int h, int fr, int fq) {
#pragma unroll
    for (int x = 0; x < 2; ++x)
#pragma unroll
        for (int ks = 0; ks < 2; ++ks) f.k[x][ks] = *(const bf16x8*)(K1 + (krow0 + 16 * x + fr) * 512 + h * 64 + 32 * ks + 8 * fq);
#pragma unroll
    for (int dt = 0; dt < 4; ++dt) { const bf16_t* vr = vbase + (size_t)(16 * dt + fr) * 8192 + 4 * fq; f.v[dt][0] = *(const u32x2*)vr; f.v[dt][1] = *(const u32x2*)(vr + 16); }
}
__device__ __forceinline__ void na_unit(const Frame& F, int u, bool stage) {
    const int b = u >> 8, h = (u >> 5) & 7, rq = u & 31;
    const int rp = 2 * rq + (F.wave >> 2), jb = F.wave & 3, lane = FLANE, fr = lane & 15, fq = lane >> 4;
    LAS bf16_t* kc = (LAS bf16_t*)F.lds;
    LAS bf16_t* vc = kc + 256 * NA_KC_PITCH;
    LAS float* rpb = (LAS float*)(vc + 64 * NA_VC_PITCH);
    const bf16_t* K1 = WSP(bf16_t, B_K1); const bf16_t* VT1 = WSP(bf16_t, B_VT1);
    if (stage) {
        __syncthreads();
        for (int i = FTID; i < 465; i += 512) rpb[i] = F.a->in[I_RPB][h * 465 + i];
        for (int i = FTID; i < 256 * 8; i += 512) { const int key = i >> 3, c8 = i & 7; *(LAS u32x4*)(kc + key * NA_KC_PITCH + 8 * c8) = *(const u32x4*)(K1 + (size_t)(b * 256 + key) * 512 + h * 64 + 8 * c8); }
        const bf16_t* vsrc = VT1 + (size_t)NB * 8 * 64 * 8192 + (size_t)(b * 8 + h) * 64 * 256;
        for (int i = FTID; i < 64 * 32; i += 512) { const int dh = i >> 5, c8 = i & 31; *(LAS u32x4*)(vc + dh * NA_VC_PITCH + 8 * c8) = *(const u32x4*)(vsrc + dh * 256 + 8 * c8); }
        __syncthreads();
    }
    const int qc = 16 * jb + fr;
    const int kstart = jb == 0 ? 0 : (jb == 1 ? 8 : (jb == 2 ? 24 : 32)), qstart = min(max(qc - 8, 0), 48);
    bf16x8 Bq[2][2];
    int r0[2];
#pragma unroll
    for (int X = 0; X < 2; ++X) { const int r = 2 * rp + X; r0[X] = min(max(r - 4, 0), 120);
#pragma unroll
        for (int ks = 0; ks < 2; ++ks) Bq[X][ks] = *(const bf16x8*)(WSP(bf16_t, B_Q1) + (size_t)(b * 8192 + r * 64 + qc) * 512 + h * 64 + 32 * ks + 8 * fq); }
    f32x4 acc[2][4];
#pragma unroll
    for (int X = 0; X < 2; ++X)
#pragma unroll
        for (int dt = 0; dt < 4; ++dt) acc[X][dt] = (f32x4){0.f, 0.f, 0.f, 0.f};
    float lsum[2] = {0.f, 0.f};
    const int rqq = u & 31;
    const int lo = min(max(4 * rqq - 4, 0), 120), hi = min(max(4 * rqq + 3 - 4, 0), 120) + 7, cnt = hi - lo + 1;
    LAS unsigned char* ring = F.lds + 73728;
    const int dkey = 8 * F.wave + (lane >> 3), dch = lane & 7, dsw = dch ^ ((dkey >> 1) & 7);
    const bf16_t* gk = K1 + ((size_t)(NCTX + b * 8192) + dkey) * 512 + h * 64 + 8 * dsw;
    const bf16_t* gv = VT1 + ((size_t)(b * 8 + h) * 64 + dkey) * 8192 + 8 * dsw;
#define NA_DMA_ROW(I) do { const int _kr = lo + (I); LAS unsigned char* _sl = ring + ((I) & 3) * 16384; \
        __builtin_amdgcn_global_load_lds((const unsigned*)(gk + (size_t)_kr * (64 * 512)), (LAS unsigned*)(_sl + F.wave * 1024), 16, 0, 0); \
        __builtin_amdgcn_global_load_lds((const unsigned*)(gv + (size_t)_kr * 64), (LAS unsigned*)(_sl + 8192 + F.wave * 1024), 16, 0, 0); } while (0)
    asm volatile("s_waitcnt vmcnt(0)" ::: "memory");
    LDS_BARRIER();
    NA_DMA_ROW(0); NA_DMA_ROW(1); NA_DMA_ROW(2);
    int kfo[2][2], vfo[4][2];
#pragma unroll
    for (int x = 0; x < 2; ++x)
#pragma unroll
        for (int ks = 0; ks < 2; ++ks) { const int key = kstart + 16 * x + fr; kfo[x][ks] = key * 128 + (((4 * ks + fq) ^ ((key >> 1) & 7)) << 4); }
#pragma unroll
    for (int dt = 0; dt < 4; ++dt)
#pragma unroll
        for (int hh = 0; hh < 2; ++hh) { const int dh = 16 * dt + fr, kb = (kstart + 4 * fq + 16 * hh) * 2;
            vfo[dt][hh] = 8192 + dh * 128 + ((((kb >> 4)) ^ ((dh >> 1) & 7)) << 4) + (kb & 15); }
#pragma unroll 1
    for (int i = 0; i < cnt; ++i) {
        const int kr = lo + i;
        if (i + 2 < cnt) asm volatile("s_waitcnt vmcnt(4)" ::: "memory"); else if (i + 1 < cnt) asm volatile("s_waitcnt vmcnt(2)" ::: "memory"); else asm volatile("s_waitcnt vmcnt(0)" ::: "memory");
        LDS_BARRIER();
        if (i + 3 < cnt) NA_DMA_ROW(i + 3);
        const LAS unsigned char* sl = ring + (i & 3) * 16384;
        if (i < 8) {
            const int it = i;
            bf16x8 kf[2][2], vf[4];
#pragma unroll
            for (int x = 0; x < 2; ++x)
#pragma unroll
                for (int ks = 0; ks < 2; ++ks) kf[x][ks] = *(const LAS bf16x8*)(kc + (32 * it + 16 * x + fr) * NA_KC_PITCH + 32 * ks + 8 * fq);
#pragma unroll
            for (int dt = 0; dt < 4; ++dt) { const LAS bf16_t* vr = vc + (16 * dt + fr) * NA_VC_PITCH + 32 * it + 4 * fq; const u32x2 lo2 = *(const LAS u32x2*)vr, hi2 = *(const LAS u32x2*)(vr + 16);
                vf[dt] = __builtin_bit_cast(bf16x8, (u32x4){lo2.x, lo2.y, hi2.x, hi2.y}); }
#pragma unroll
            for (int X = 0; X < 2; ++X) {
                f32x4 st[2];
#pragma unroll
                for (int x = 0; x < 2; ++x) {
                    f32x4 a4 = (f32x4){0.f, 0.f, 0.f, 0.f};
                    a4 = __builtin_amdgcn_mfma_f32_16x16x32_bf16(kf[x][0], Bq[X][0], a4, 0, 0, 0);
                    a4 = __builtin_amdgcn_mfma_f32_16x16x32_bf16(kf[x][1], Bq[X][1], a4, 0, 0, 0);
#pragma unroll
                    for (int q = 0; q < 4; ++q) { const float p = __expf(a4[q]); a4[q] = p; lsum[X] += p; }
                    st[x] = a4;
                }
                const bf16x8 P = __builtin_bit_cast(bf16x8, pack8(st[0], st[1]));
#pragma unroll
                for (int dt = 0; dt < 4; ++dt) acc[X][dt] = __builtin_amdgcn_mfma_f32_16x16x32_bf16(vf[dt], P, acc[X][dt], 0, 0, 0);
            }
        }
        if (kr >= r0[0] && kr < r0[1] + 8) {
            bf16x8 ck[2][2]; u32x2 cv[4][2];
#pragma unroll
            for (int x = 0; x < 2; ++x)
#pragma unroll
                for (int ks = 0; ks < 2; ++ks) ck[x][ks] = *(const LAS bf16x8*)(sl + kfo[x][ks]);
#pragma unroll
            for (int dt = 0; dt < 4; ++dt) { cv[dt][0] = *(const LAS u32x2*)(sl + vfo[dt][0]); cv[dt][1] = *(const LAS u32x2*)(sl + vfo[dt][1]); }
#pragma unroll
            for (int X = 0; X < 2; ++X) {
                const int r = 2 * rp + X;
                if (kr >= r0[X] && kr < r0[X] + 8) {
                    f32x4 st[2];
#pragma unroll
                    for (int x = 0; x < 2; ++x) {
                        f32x4 a4 = (f32x4){0.f, 0.f, 0.f, 0.f};
                        a4 = __builtin_amdgcn_mfma_f32_16x16x32_bf16(ck[x][0], Bq[X][0], a4, 0, 0, 0);
                        a4 = __builtin_amdgcn_mfma_f32_16x16x32_bf16(ck[x][1], Bq[X][1], a4, 0, 0, 0);
#pragma unroll
                        for (int q = 0; q < 4; ++q) {
                            const int kcn = kstart + 16 * x + 4 * fq + q; const float vm = (kcn >= qstart && kcn < qstart + 16) ? 1.f : 0.f;
                            const int ci = min(max(kcn - qc + 15, 0), 30), ri = kr - r + 7;
                            const float p = __expf(a4[q] + rpb[ri * 31 + ci]) * vm;
                            a4[q] = p; lsum[X] += p;
                        }
                        st[x] = a4;
                    }
                    const bf16x8 P = __builtin_bit_cast(bf16x8, pack8(st[0], st[1]));
#pragma unroll
                    for (int dt = 0; dt < 4; ++dt)
                        acc[X][dt] = __builtin_amdgcn_mfma_f32_16x16x32_bf16(__builtin_bit_cast(bf16x8, (u32x4){cv[dt][0].x, cv[dt][0].y, cv[dt][1].x, cv[dt][1].y}), P, acc[X][dt], 0, 0, 0);
                }
            }
        }
    }
#undef NA_DMA_ROW
#pragma unroll
    for (int X = 0; X < 2; ++X) {
        float ls = lsum[X]; ls += __shfl_xor(ls, 16); ls += __shfl_xor(ls, 32);
        const float inv = 1.f / ls;
        bf16_t* o = WSP(bf16_t, B_MIX1) + (size_t)(b * 8192 + (2 * rp + X) * 64 + qc) * 1024 + h * 64 + 4 * fq;
#pragma unroll
        for (int dt = 0; dt < 4; ++dt) { u32x2 w; w.x = pk2(acc[X][dt][0] * inv, acc[X][dt][1] * inv); w.y = pk2(acc[X][dt][2] * inv, acc[X][dt][3] * inv); *(u32x2*)(o + 16 * dt) = w; }
    }
}
constexpr int NPHASE = 22;
constexpr int CW_BAR = 4096;
#ifndef N_LAUNCH_SPLIT
#define N_LAUNCH_SPLIT 0
#endif


__global__ void __launch_bounds__(512, 2) fwd_kernel(Args args) {
    extern __shared__ __attribute__((aligned(16))) unsigned char lds_raw[];
    Frame F;
    F.lds = (LAS unsigned char*)lds_raw; F.a = &args; F.ws = args.ws;
    F.wave = __builtin_amdgcn_readfirstlane(FTID >> 6); F.G = gridDim.x; F.bid = blockIdx.x;
    volatile LAS unsigned* st = (volatile LAS unsigned*)(F.lds + LDSCTL_OFF);
    if (FTID < 16) st[FTID] = 0u;
    __syncthreads();
    const int lo = args.ph_lo, hi = args.ph_hi, sub = args.sub;
    XcdBarrier bar; bar.bar = (unsigned*)(F.ws + M_CTL) + CW_BAR + args.li * XCD_BAR_WORDS; bar.x = 0; bar.st = st;
    if (hi - lo > 1) bar = xcd_barrier_post((unsigned*)(F.ws + M_CTL) + CW_BAR + args.li * XCD_BAR_WORDS, st);
#ifdef ONLY_PHASE
#define IN(k) ((k) == ONLY_PHASE && lo <= (k) && (k) < hi)
#else
#define IN(k) (lo <= (k) && (k) < hi)
#endif
#define SEAM(k) do { if (IN(k) && IN((k) + 1)) xcd_barrier(bar); } while (0)
    const char* ws = (const char*)F.ws;

    if (IN(0)) { phase0(F); } SEAM(0);
    if (sub >= 100 && hi - lo > 1) for (int i = 100; i < sub; ++i) xcd_barrier(bar);
    if (IN(1)) { phase1_norm0(F); } SEAM(1);
    if (IN(2)) {
        EpiIn0 E{WSP(bf16_t, B_QK), WSP(bf16_t, B_VT), WSP(bf16_t, B_G), WSP(bf16_t, B_AS5), WSP(bf16_t, B_LA), args.in[I_BA]};
        SchedDense S; S.ord.init(NTOK / 256, 10, F.G, F.bid); S.A = ws + B_ABUF; S.Bt = ws + W_IN0; S.atile = (size_t)256 * 1024 * 2; S.btile = (size_t)256 * 1024 * 2; S.pm_off = 0; S.swap_lo = 2; S.swap_hi = 4;
        g8::gemm_phase<EpiIn0, SchedDense, false>(F.lds, 1024, 1024, S, E);
        tail_conv(F, S.ord.nwg, 0, 0, TC_L0_A);
    } SEAM(2);
    if (IN(3)) {
        if (sub != 2) for (int u = F.bid; u < GNCH; u += F.G) gla_c1_unit(F, u);
        __syncthreads();
        if (sub != 1) {
        EpiS1 E{WSP(float, B_ZS5)};
        const int nx = GNCH % F.G; SchedS5 S{ws + B_AS5, ws + W_S1, 1, S5KU, F.G - nx, F.bid - nx};
        g8::gemm_phase<EpiS1, SchedS5, false>(F.lds, S5K, S5KU, S, E);
        idle_conv(F, nx + 32 * 5 * 1, 0, TC_L0_A, TC_L0_B);
        }
    } SEAM(3);
    if (IN(4)) { if (F.G == 256 && sub == 0) scans_fused(F); else { if (sub != 2) gla_scan(F); if (sub != 1) s5_scan(F); } } SEAM(4);
    if (IN(5)) {
#if !defined(SUB) || SUB == 1
        if (sub != 2) for (int u = F.bid; u < GNCH; u += F.G) gla_c3_unit(F, u, sub >> 4);
        __syncthreads();
#endif
#if !defined(SUB) || SUB == 2
        if (sub != 1) {
        EpiS3 E{WSP(bf16_t, B_YG)};
        const int nx = GNCH % F.G; SchedS5 S{ws + B_AS5, ws + W_S3, 2, S5K, F.G - nx, F.bid - nx};
        g8::gemm_phase<EpiS3, SchedS5, false>(F.lds, S5K, S5K, S, E);
        { const int U = 32 * 5 * 2, Gs = F.G - nx, tl = U % Gs, busy = 2 * tl <= Gs ? 2 * tl : tl; idle_conv(F, nx + busy, 0, TC_L0_B, TC_L0_C); }
        }
#endif
    } SEAM(5);
    if (IN(6)) {
        EpiGlu E{WSP(bf16_t, B_YG), WSP(bf16_t, B_MIX0)};
        SchedDense S; S.ord.init(NTOK / 256, 2, F.G, F.bid); S.A = ws + B_YG; S.Bt = ws + W_GLU; S.atile = (size_t)256 * 512 * 2; S.btile = (size_t)256 * 512 * 2; S.pm_off = 0;
        g8::gemm_phase<EpiGlu, SchedDense, false>(F.lds, 512, 512, S, E);
        tail_conv(F, S.ord.nwg, 0, TC_L0_C, TC_L0_D);
    } SEAM(6);
    if (IN(7)) {
        EpiOut E{args.in[I_X], args.in[I_CTX], WSP(bf16_t, B_X1), WSP(float, M_MOD), 0};
        SchedDense S; S.ord.init(NTOK / 256, 4, F.G, F.bid); S.A = ws + B_MIX0; S.Bt = ws + W_OUT0; S.atile = (size_t)256 * 1024 * 2; S.btile = (size_t)256 * 1024 * 2; S.pm_off = 0;
        g8::gemm_phase<EpiOut, SchedDense, false>(F.lds, 1024, 1024, S, E);
        tail_conv(F, S.ord.nwg, 0, TC_L0_D, 32 * 512);
    } SEAM(7);
#ifdef ROUTER_PROBE
    if (IN(8)) { router_phase(F, 0, sub == 5 ? -1 : 2, sub == 6 || sub == 7); } SEAM(8);
#else
    if (IN(8)) { router_phase(F, 0, 2); } SEAM(8);
#endif
    if (IN(9)) { placement_phase(F, 0); } SEAM(9);
    if (IN(10)) {
        EpiM1 E{WSP(bf16_t, B_ACT)};
        SchedMoe S{WSP(int, M_TILES), WSP(int, M_TOKBUF), ws + B_ABUF, ws + W_M13, (size_t)1024 * 1024 * 2, (size_t)256 * 1024 * 2, 0, F.G, F.bid, 1};
        g8::gemm_phase<EpiM1, SchedMoe, true>(F.lds, 1024, 1024, S, E);
        tail_conv(F, S.tiles[0] * 4, 1, 0, TC_L1_A);
    } SEAM(10);
    if (IN(11)) {
        EpiM2 E{WSP(bf16_t, B_YB)};
        SchedMoe S{WSP(int, M_TILES), WSP(int, M_TOKBUF), ws + B_ACT, ws + W_M2, (size_t)1024 * 512 * 2, (size_t)256 * 512 * 2, (size_t)256 * 512 * 2, F.G, F.bid, 0};
        g8::gemm_phase<EpiM2, SchedMoe, false>(F.lds, 512, 512, S, E);
        tail_conv(F, S.tiles[0] * 4, 1, TC_L1_A, TC_L1_B);
    } SEAM(11);
    if (IN(12)) {
        if (sub != 2) combine_norm1_phase(F);
        if (sub != 1) for (int u = F.bid; u < 256; u += F.G) hf_unit(F, u);
    } SEAM(12);
    if (IN(13)) {
#ifdef GEMM_PROBE
        EpiIn1 E{WSP(bf16_t, B_Q1), WSP(bf16_t, B_K1), WSP(bf16_t, B_VT1), WSP(bf16_t, B_ZHT), sub >= 4 ? 1 : 0};
        SchedIn1 S; S.ord.init(NLAT / 256, 12, F.G, F.bid); S.A = ws + B_ABUF; S.Bt = ws + W_IN1; S.G = F.G; S.c = F.bid;
        if (sub != 2) g8::gemm_phase<EpiIn1, SchedIn1, false>(F.lds, 1024, (sub == 3 || sub == 5) ? 512 : 1024, S, E);
#else
        EpiIn1 E{WSP(bf16_t, B_Q1), WSP(bf16_t, B_K1), WSP(bf16_t, B_VT1), WSP(bf16_t, B_ZHT), args.in[I_QN], args.in[I_KN], (LAS float*)(F.lds + 8 * g8::HTB)};
        SchedIn1 S; S.ord.init(NLAT / 256, 12, F.G, F.bid); S.A = ws + B_ABUF; S.Bt = ws + W_IN1; S.G = F.G; S.c = F.bid;
        if (sub != 2) g8::gemm_phase<EpiIn1, SchedIn1, false>(F.lds, 1024, 1024, S, E);
        tail_conv(F, S.ord.nwg + 16, 1, TC_L1_B, TC_L1_C);
#endif
        if (sub == 0 || sub == 2) for (int u = F.bid; u < 512; u += F.G) kf_unit(F, u, u == F.bid);
    } SEAM(13);
    if (IN(14)) {
#if !defined(SUB) || SUB == 1
#endif
#if !defined(SUB) || SUB == 2
        if (sub != 1) {
            const int vb = (F.G & 7) == 0 ? (F.bid & 7) * (F.G >> 3) + (F.bid >> 3) : F.bid;
            for (int u = vb; u < 1024; u += F.G) hyconv_unit(F, u, sub >> 4, u == vb);
        }
#endif
    } SEAM(14);
    if (IN(15)) {
#if !defined(SUB) || SUB == 1
        if (sub != 2) {
            const int vb = (F.G & 7) == 0 ? (F.bid & 7) * (F.G >> 3) + (F.bid >> 3) : F.bid;
            const int per = (1024 + F.G - 1) / F.G; for (int k = 0; k < per; ++k) { const int u = vb * per + k; if (u < 1024) na_unit(F, u, k == 0 || (u & 31) == 0); } }
        __syncthreads();
#endif
#if !defined(SUB) || SUB == 2
        if (sub != 1) {
        LAS bf16_t* scr = (LAS bf16_t*)(F.lds + F.wave * 16384);
        for (int it = F.bid * 8 + F.wave; it < 8 * 512; it += F.G * 8) hy_transpose_item(F, it, scr);
        }
#endif
    } SEAM(15);
    if (IN(16)) {
        EpiOut E{args.in[I_X], args.in[I_CTX], WSP(bf16_t, B_X1), WSP(float, M_MOD) + 5 * 6144, 1};
        SchedDense S; S.ord.init(NLAT / 256, 4, F.G, F.bid); S.A = ws + B_MIX1; S.Bt = ws + W_OUT1; S.atile = (size_t)256 * 1024 * 2; S.btile = (size_t)256 * 1024 * 2; S.pm_off = 4;
        g8::gemm_phase<EpiOut, SchedDense, false>(F.lds, 1024, 1024, S, E);
    } SEAM(16);
    if (IN(17)) {
        router_phase(F, 1, 3);
    } SEAM(17);
    if (IN(18)) { placement_phase(F, 1); } SEAM(18);
    if (IN(19)) {
        EpiM1 E{WSP(bf16_t, B_ACT)};
        SchedMoe S{WSP(int, M_TILES), WSP(int, M_TOKBUF), ws + B_ABUF, ws + W_M13B, (size_t)1024 * 1024 * 2, (size_t)256 * 1024 * 2, 0, F.G, F.bid, 1};
        g8::gemm_phase<EpiM1, SchedMoe, true>(F.lds, 1024, 1024, S, E);
    } SEAM(19);
    if (IN(20)) {
        EpiM2 E{WSP(bf16_t, B_YB)};
        SchedMoe S{WSP(int, M_TILES), WSP(int, M_TOKBUF), ws + B_ACT, ws + W_M2, (size_t)1024 * 512 * 2, (size_t)256 * 512 * 2, (size_t)256 * 512 * 2, F.G, F.bid, 0};
        g8::gemm_phase<EpiM2, SchedMoe, false>(F.lds, 512, 512, S, E);
    } SEAM(20);
    if (IN(21)) { final_phase(F); }
#undef IN
#undef SEAM
}

extern "C" void kernel_launch(void* const* d_in, const int* in_sizes, int n_in, void* d_out, int out_size, void* d_ws, size_t ws_size, hipStream_t stream) {
    static int grid = 0;
    if (grid == 0) {
        if (n_in != 43 || out_size != NLAT * D || ws_size < WS_END) { fprintf(stderr, "kernel_launch: unexpected shapes (n_in %d out %d ws %zu)\n", n_in, out_size, ws_size); grid = -1; return; }
        int dev = 0, cus = 0, per_cu = 0;
        if (hipGetDevice(&dev) != hipSuccess || hipDeviceGetAttribute(&cus, hipDeviceAttributeMultiprocessorCount, dev) != hipSuccess) { grid = -1; return; }
        if (hipFuncSetAttribute((const void*)fwd_kernel, hipFuncAttributeMaxDynamicSharedMemorySize, LDS_BYTES) != hipSuccess) { fprintf(stderr, "kernel_launch: hipFuncSetAttribute failed\n"); grid = -1; return; }
        if (hipOccupancyMaxActiveBlocksPerMultiprocessor(&per_cu, (const void*)fwd_kernel, 512, LDS_BYTES) != hipSuccess || per_cu < 1) { fprintf(stderr, "kernel_launch: occupancy query says %d\n", per_cu); per_cu = 1; }
        (void)hipGetLastError();
        grid = cus < 256 ? cus : 256;
    }
    if (grid < 0) return;
    (void)hipMemsetAsync((char*)d_ws + M_CTL, 0, CTL_BYTES, stream);
    Args a{};
    for (int i = 0; i < 43; ++i) a.in[i] = (const float*)d_in[i];
    a.out = (float*)d_out; a.ws = (unsigned char*)d_ws;
#if N_LAUNCH_SPLIT
    a.sub = 0; a.li = 0;
    for (int p = 0; p < NPHASE; ++p) { a.ph_lo = p; a.ph_hi = p + 1; hipLaunchKernelGGL(fwd_kernel, dim3(grid), dim3(512), LDS_BYTES, stream, a); }
#elif defined(PROBE_BARRIERS)
    a.ph_lo = 0; a.ph_hi = NPHASE; a.sub = 100 + PROBE_BARRIERS; a.li = 0;
    { void* kargs[] = {&a}; hipLaunchCooperativeKernel((const void*)fwd_kernel, dim3(grid), dim3(512), kargs, LDS_BYTES, stream); }
#elif defined(PROBE_PHASE)
    { void* kargs[] = {&a};
      if (PROBE_PHASE > 0) { a.ph_lo = 0; a.ph_hi = PROBE_PHASE; a.sub = 0; a.li = 0; hipLaunchCooperativeKernel((const void*)fwd_kernel, dim3(grid), dim3(512), kargs, LDS_BYTES, stream); }
      for (int r = 0; r < PROBE_EXTRA; ++r) { a.ph_lo = PROBE_PHASE; a.ph_hi = PROBE_PHASE + 1; a.sub = PROBE_SUB; a.li = 1;
        hipLaunchCooperativeKernel((const void*)fwd_kernel, dim3(grid), dim3(512), kargs, LDS_BYTES, stream); }
      a.ph_lo = PROBE_PHASE; a.ph_hi = NPHASE; a.sub = 0; a.li = 2;
      hipLaunchCooperativeKernel((const void*)fwd_kernel, dim3(grid), dim3(512), kargs, LDS_BYTES, stream); }
#else
    a.ph_lo = 0; a.ph_hi = NPHASE; a.sub = 0; a.li = 0;
    void* kargs[] = {&a};
    hipError_t e = hipLaunchCooperativeKernel((const void*)fwd_kernel, dim3(grid), dim3(512), kargs, LDS_BYTES, stream);
    if (e != hipSuccess) fprintf(stderr, "cooperative launch failed: %s (grid %d)\n", hipGetErrorString(e), grid);
#endif
}
```
